# Optimizing an MI355X kernel written in HIP

```python
import math
import jax
import jax.numpy as jnp
from jax import lax
import numpy as np

D_MODEL = 1024
BATCH = 16
SEQ = 2048
DEPTH = 4

GRID_W = 64
CTX_LEN = 256
N_BRANCH = 4
BR_WIDTH = D_MODEL // 4
DA_HEADS = 4
DA_DV = BR_WIDTH // DA_HEADS
DA_DH = DA_DV // 2
NA_HEADS = 4
NA_DH = BR_WIDTH // NA_HEADS
NA_WIN_H = 8
NA_WIN_W = 16
HG_HEADS = 4
HG_DK = BR_WIDTH // HG_HEADS
HG_DV = BR_WIDTH // HG_HEADS
HG_CHUNK = 64
LB_FLOOR = 1e-20
FT_GROUPS = 4
FT_DG = BR_WIDTH // FT_GROUPS
SPLIT_IDX = [3 * BR_WIDTH, 6 * BR_WIDTH, 10 * BR_WIDTH, 11 * BR_WIDTH]
IN_WIDTH = 15 * BR_WIDTH
Q_BLOCK = 128
ROPE_THETA = 10000.0
EPS = 1e-6
NEG_INF = -1e30

kernel_name = 'hybrid_diffusion_parallel_mixers'


def rmsnorm(x, gain):
    xf = x.astype(jnp.float32)
    y = xf * lax.rsqrt(jnp.mean(xf * xf, axis=-1, keepdims=True) + EPS)
    return (y * gain.astype(jnp.float32)).astype(x.dtype)


def axial_rope(n, dim):
    t = jnp.arange(n)
    row = (t // GRID_W).astype(jnp.float32)
    col = (t % GRID_W).astype(jnp.float32)
    d_axis = dim // 2
    inv = ROPE_THETA ** (-jnp.arange(0, d_axis, 2, dtype=jnp.float32) / d_axis)
    ang = jnp.concatenate([row[:, None] * inv, col[:, None] * inv], axis=-1)
    return jnp.cos(ang), jnp.sin(ang)


def apply_rope(x, cos, sin):
    x1, x2 = jnp.split(x, 2, axis=-1)
    c = cos[None, :, None, :].astype(x.dtype)
    s = sin[None, :, None, :].astype(x.dtype)
    return jnp.concatenate([x1 * c - x2 * s, x1 * s + x2 * c], axis=-1)


def softmax_attention(q, k, v):
    s = jnp.einsum('bqhd,bkhd->bhqk', q, k, preferred_element_type=jnp.float32) * (q.shape[-1] ** -0.5)
    p = jax.nn.softmax(s, axis=-1).astype(v.dtype)
    return jnp.einsum('bhqk,bkhd->bqhd', p, v)


def diff_softmax_attention(q, k, v, lam):
    b, nq = q.shape[:2]
    nk = k.shape[1]
    nb = nq // Q_BLOCK
    scale = DA_DH ** -0.5
    qb = q.reshape(b, nb, Q_BLOCK, 2 * DA_HEADS, DA_DH).swapaxes(0, 1)

    def block(qi):
        s = jnp.einsum('bqhd,bkhd->bhqk', qi, k, preferred_element_type=jnp.float32) * scale
        p = jax.nn.softmax(s, axis=-1).reshape(b, DA_HEADS, 2, Q_BLOCK, nk)
        a = p[:, :, 0] - lam * p[:, :, 1]
        return jnp.einsum('bhqk,bkhe->bqhe', a.astype(v.dtype), v)

    o = lax.map(block, qb)
    return o.swapaxes(0, 1).reshape(b, nq, DA_HEADS, DA_DV)


def mixer_diff_attn(z, zc, qk_gain, lam_vec, subln_gain, lam_init, cos, sin, need_ctx):
    def project(t):
        b, n, _ = t.shape
        q, k, v = jnp.split(t, 3, axis=-1)
        q = rmsnorm(q.reshape(b, n, 2 * DA_HEADS, DA_DH), qk_gain[0])
        k = rmsnorm(k.reshape(b, n, 2 * DA_HEADS, DA_DH), qk_gain[1])
        return q, k, v.reshape(b, n, DA_HEADS, DA_DV)

    lv = lam_vec.astype(jnp.float32)
    lam = jnp.exp(jnp.sum(lv[0] * lv[1])) - jnp.exp(jnp.sum(lv[2] * lv[3])) + lam_init
    q, k, v = project(z)
    q = apply_rope(q, cos, sin)
    k = apply_rope(k, cos, sin)
    qc, kc, vc = project(zc)

    def finish(o):
        b, n = o.shape[:2]
        return (rmsnorm(o, subln_gain) * (1.0 - lam_init)).reshape(b, n, BR_WIDTH)

    y = finish(diff_softmax_attention(q, jnp.concatenate([k, kc], axis=1), jnp.concatenate([v, vc], axis=1), lam))
    yc = finish(diff_softmax_attention(qc, kc, vc, lam)) if need_ctx else None
    return y, yc


def neighbourhood_attention(q, k, v, kc, vc, rpb):
    b, n, h, dh = q.shape
    rows = n // GRID_W
    wh = min(NA_WIN_H, rows)
    ww = NA_WIN_W
    scale = dh ** -0.5
    r = jnp.arange(rows)
    col = jnp.arange(GRID_W)
    r0 = jnp.clip(r - wh // 2, 0, rows - wh)
    key_rows = r0[:, None] + jnp.arange(wh)[None, :]
    c0 = jnp.clip(col - ww // 2, 0, GRID_W - ww)
    in_win = (col[None, :] >= c0[:, None]) & (col[None, :] < c0[:, None] + ww)
    dr = key_rows - r[:, None] + NA_WIN_H - 1
    dc = jnp.clip(col[None, :] - col[:, None], 1 - ww, ww - 1) + ww - 1
    bias = rpb.astype(jnp.float32)[:, dr[:, :, None, None], dc[None, None, :, :]]
    bias = jnp.where(in_win[None, None, None], bias, NEG_INF).transpose(1, 3, 0, 2, 4)
    qg = q.reshape(b, rows, GRID_W, h, dh)
    kg = k.reshape(b, rows, GRID_W, h, dh)[:, key_rows]
    vg = v.reshape(b, rows, GRID_W, h, dh)[:, key_rows]
    s_win = jnp.einsum('brqhd,brjkhd->brqhjk', qg, kg, preferred_element_type=jnp.float32) * scale + bias
    s_ctx = jnp.einsum('brqhd,blhd->brqhl', qg, kc, preferred_element_type=jnp.float32) * scale
    nw = wh * GRID_W
    s = jnp.concatenate([s_win.reshape(b, rows, GRID_W, h, nw), s_ctx], axis=-1)
    p = jax.nn.softmax(s, axis=-1).astype(v.dtype)
    p_win = p[..., :nw].reshape(b, rows, GRID_W, h, wh, GRID_W)
    o = jnp.einsum('brqhjk,brjkhd->brqhd', p_win, vg) + jnp.einsum('brqhl,blhd->brqhd', p[..., nw:], vc)
    return o.reshape(b, n, h, dh)


def mixer_neigh_attn(z, zc, qk_gain, rpb, need_ctx):
    def project(t):
        b, n, _ = t.shape
        q, k, v = [u.reshape(b, n, NA_HEADS, NA_DH) for u in jnp.split(t, 3, axis=-1)]
        return rmsnorm(q, qk_gain[0]), rmsnorm(k, qk_gain[1]), v

    b, n, _ = z.shape
    q, k, v = project(z)
    qc, kc, vc = project(zc)
    y = neighbourhood_attention(q, k, v, kc, vc, rpb).reshape(b, n, BR_WIDTH)
    yc = softmax_attention(qc, kc, vc).reshape(b, zc.shape[1], BR_WIDTH) if need_ctx else None
    return y, yc


def hgrn2_scan(q, v, log_f, s0, with_output=True):
    b, n, h, _ = q.shape
    nc = n // HG_CHUNK

    def chunks(t):
        return t.reshape(b, nc, HG_CHUNK, h, t.shape[-1]).transpose(1, 0, 3, 2, 4)

    causal = jnp.tril(jnp.ones((HG_CHUNK, HG_CHUNK), dtype=bool))[:, :, None]

    def step(S, inp):
        qi, vi, gi = inp
        bcum = jnp.cumsum(gi, axis=2)
        ki = -jnp.expm1(gi)
        b_last = bcum[:, :, -1:, :]
        S_new = jnp.exp(b_last)[:, :, 0, :, None] * S + jnp.einsum('bhsd,bhse->bhde', ki * jnp.exp(b_last - bcum), vi)
        if not with_output:
            return S_new, None
        rel = bcum[:, :, :, None, :] - bcum[:, :, None, :, :]
        decay = jnp.where(causal, jnp.exp(jnp.minimum(rel, 0.0)), 0.0)
        att = jnp.einsum('bhtd,bhsd,bhtsd->bhts', qi, ki, decay)
        o = jnp.einsum('bhts,bhse->bhte', att, vi) + jnp.einsum('bhtd,bhde->bhte', qi * jnp.exp(bcum), S)
        return S_new, o

    s_fin, o = lax.scan(step, s0, (chunks(q), chunks(v), chunks(log_f)))
    if not with_output:
        return None, s_fin
    return o.transpose(1, 0, 3, 2, 4).reshape(b, n, h, v.shape[-1]), s_fin


def mixer_hgrn2(z, zc, lb, onorm_gain, need_ctx):
    log_lb = jnp.log(jnp.maximum(lb, LB_FLOOR))
    log_1mlb = jnp.log1p(-lb)

    def prep(t):
        b, n, _ = t.shape
        q, ff, fb, i = jnp.split(t.astype(jnp.float32), 4, axis=-1)

        def log_forget(f, d):
            return jnp.logaddexp(log_lb[d], log_1mlb[d] + jax.nn.log_sigmoid(f)).reshape(b, n, HG_HEADS, HG_DK)

        return (jax.nn.silu(q).reshape(b, n, HG_HEADS, HG_DK), log_forget(ff, 0), log_forget(fb, 1),
                i.reshape(b, n, HG_HEADS, HG_DV))

    def flip(t):
        return jnp.flip(t, axis=1)

    b, n, _ = z.shape
    q, g_f, g_b, i = prep(z)
    qc, gc_f, gc_b, ic = prep(zc)
    s0 = jnp.zeros((b, HG_HEADS, HG_DK, HG_DV), jnp.float32)
    oc_f, sc_f = hgrn2_scan(qc, ic, gc_f, s0, need_ctx)
    oc_b, sc_b = hgrn2_scan(flip(qc), flip(ic), flip(gc_b), s0, need_ctx)
    o_f, _ = hgrn2_scan(q, i, g_f, sc_f)
    o_b, _ = hgrn2_scan(flip(q), flip(i), flip(g_b), sc_b)

    def finish(o, m):
        return rmsnorm(o, onorm_gain).reshape(b, m, BR_WIDTH).astype(z.dtype)

    y = finish(o_f + flip(o_b), n)
    yc = finish(oc_f + flip(oc_b), zc.shape[1]) if need_ctx else None
    return y, yc


def fourier_mix(u):
    b, n, _ = u.shape
    ug = u.astype(jnp.float32).reshape(b, n, FT_GROUPS, FT_DG)
    return jnp.fft.fft2(ug, axes=(1, 3), norm='ortho').real.reshape(b, n, BR_WIDTH).astype(u.dtype)


def merge_branches(h, ys, g, w_up_l, w_merge_l, w_out_l):
    gs = jnp.split(g, N_BRANCH, axis=-1)
    acc = None
    for i in range(N_BRANCH):
        branch = (ys[i] * jax.nn.silu(gs[i])) @ w_up_l[i]
        term = jax.nn.sigmoid(h @ w_merge_l[i]) * branch
        acc = term if acc is None else acc + term
    return acc @ w_out_l


def setup_inputs(seed: int = 0) -> dict:
    key = jax.random.key(seed)
    ks = jax.random.split(key, 18)

    def nrm(k, shape, s):
        return jax.random.normal(k, shape, jnp.float32) * s

    return {
        'x': nrm(ks[0], (BATCH, SEQ, D_MODEL), 1.0),
        'c': nrm(ks[1], (BATCH, D_MODEL), 1.0),
        'ctx': nrm(ks[2], (BATCH, CTX_LEN, D_MODEL), 1.0),
        'c_ctx': nrm(ks[3], (D_MODEL,), 1.0),
        'norm_gain': 1.0 + nrm(ks[4], (DEPTH, D_MODEL), 0.02),
        'w_mod': nrm(ks[5], (DEPTH, D_MODEL, 3 * D_MODEL), 0.5 * D_MODEL ** -0.5),
        'b_mod': nrm(ks[6], (DEPTH, 3 * D_MODEL), 0.01),
        'w_in': nrm(ks[7], (DEPTH, D_MODEL, IN_WIDTH), D_MODEL ** -0.5),
        'da_qk_gain': 1.0 + nrm(ks[8], (DEPTH, 2, DA_DH), 0.02),
        'da_lambda': nrm(ks[9], (DEPTH, 4, DA_DH), 0.1),
        'da_subln_gain': 1.0 + nrm(ks[10], (DEPTH, DA_DV), 0.02),
        'na_qk_gain': 1.0 + nrm(ks[11], (DEPTH, 2, NA_DH), 0.02),
        'na_rpb': nrm(ks[12], (DEPTH, NA_HEADS, 2 * NA_WIN_H - 1, 2 * NA_WIN_W - 1), 0.2),
        'hg_lb_logits': nrm(ks[13], (2, DEPTH, BR_WIDTH), 0.5),
        'hg_norm_gain': 1.0 + nrm(ks[14], (DEPTH, HG_DV), 0.02),
        'w_up': nrm(ks[15], (DEPTH, N_BRANCH, BR_WIDTH, D_MODEL), BR_WIDTH ** -0.5),
        'w_merge': nrm(ks[16], (DEPTH, N_BRANCH, D_MODEL, D_MODEL), D_MODEL ** -0.5),
        'w_out': nrm(ks[17], (DEPTH, D_MODEL, D_MODEL), D_MODEL ** -0.5),
    }


def reference(x, c, ctx, c_ctx, norm_gain, w_mod, b_mod, w_in, da_qk_gain, da_lambda, da_subln_gain,
              na_qk_gain, na_rpb, hg_lb_logits, hg_norm_gain, w_up, w_merge, w_out):
    n = x.shape[1]
    cos, sin = axial_rope(n, DA_DH)
    p_lb = jax.nn.softmax(hg_lb_logits.astype(jnp.float32), axis=1)
    lower_bounds = jnp.cumsum(p_lb, axis=1) - p_lb[:, :1]
    silu_c = jax.nn.silu(c)
    silu_cc = jax.nn.silu(c_ctx)
    xc = ctx
    for l in range(DEPTH):
        need_ctx = l < DEPTH - 1
        lam_init = 0.8 - 0.6 * math.exp(-0.3 * l)
        shift, scale, gate = jnp.split((silu_c @ w_mod[l] + b_mod[l])[:, None, :], 3, axis=-1)
        shift_c, scale_c, gate_c = jnp.split(silu_cc @ w_mod[l] + b_mod[l], 3)
        h = rmsnorm(x, norm_gain[l]) * (1.0 + scale) + shift
        hc = rmsnorm(xc, norm_gain[l]) * (1.0 + scale_c) + shift_c
        za, zb, zh, zf, zg = jnp.split(h @ w_in[l], SPLIT_IDX, axis=-1)
        zc = hc @ (w_in[l] if need_ctx else w_in[l][:, :SPLIT_IDX[2]])
        zc_parts = jnp.split(zc, SPLIT_IDX if need_ctx else SPLIT_IDX[:2], axis=-1)
        ya, yca = mixer_diff_attn(za, zc_parts[0], da_qk_gain[l], da_lambda[l], da_subln_gain[l], lam_init, cos, sin, need_ctx)
        yb, ycb = mixer_neigh_attn(zb, zc_parts[1], na_qk_gain[l], na_rpb[l], need_ctx)
        yh, ych = mixer_hgrn2(zh, zc_parts[2], lower_bounds[:, l], hg_norm_gain[l], need_ctx)
        yf = fourier_mix(zf)
        x = x + gate * merge_branches(h, (ya, yb, yh, yf), zg, w_up[l], w_merge[l], w_out[l])
        if need_ctx:
            ycf = fourier_mix(zc_parts[3])
            xc = xc + gate_c * merge_branches(hc, (yca, ycb, ych, ycf), zc_parts[4], w_up[l], w_merge[l], w_out[l])
    return x
```

```cpp
#include <hip/hip_runtime.h>
#include <hip/hip_cooperative_groups.h>
#include <cstdio>
namespace cg = cooperative_groups;

#ifndef COOP
#define COOP 1
#endif

#define LAS __attribute__((address_space(3)))
#define DI __device__ __forceinline__
typedef unsigned short bf16_t;
typedef short bf16x8 __attribute__((ext_vector_type(8)));
typedef float f32x4 __attribute__((ext_vector_type(4)));
typedef float f32x16 __attribute__((ext_vector_type(16)));
typedef unsigned u32x4 __attribute__((ext_vector_type(4)));
typedef unsigned u32x2 __attribute__((ext_vector_type(2)));

constexpr int DM = 1024, NB = 16, SEQ = 2048, DEPTH = 4, CTX = 256;
constexpr int TL = NB * SEQ, TC = NB * CTX, TT = TL + TC;
constexpr int KEYS = SEQ + CTX;
constexpr int NSLOT = KEYS / 64;
constexpr float EPS = 1e-6f;
constexpr float LOG2E = 1.4426950408889634f;

constexpr size_t SZ_XC = (size_t)TC * DM * 4;
constexpr size_t SZ_MOD = 1u << 20;
constexpr size_t SZ_MISC = 1u << 16;
constexpr size_t SZ_WIN = (size_t)4096 * 1024 * 2, SZ_WUP = (size_t)1024 * 1024 * 2, SZ_WM = (size_t)4096 * 1024 * 2, SZ_WO = (size_t)1024 * 1024 * 2;
constexpr size_t SZ_DFTL = (size_t)2048 * 4096 * 2, SZ_DFTC = (size_t)256 * 512 * 2;
constexpr size_t SZ_TOK256 = (size_t)TT * 256 * 2;
constexpr size_t SZ_TOK1024 = (size_t)TT * 1024 * 2;
constexpr size_t SZ_VT = (size_t)NB * 256 * KEYS * 2;
constexpr size_t SZ_EV = (size_t)2 * NB * NSLOT * 3 * 256 * 4;
constexpr size_t SZ_FBL = (size_t)4096 * 4096 * 2, SZ_FBC = (size_t)4096 * 512 * 2;
constexpr size_t SZ_G = (size_t)2 * TT * 256 * 4;
constexpr size_t SZ_SCR = (size_t)256 * 512 * 128 * 4;

constexpr size_t OFF_XC = 0;
constexpr size_t OFF_MOD = OFF_XC + SZ_XC;
constexpr size_t OFF_MISC = OFF_MOD + SZ_MOD;
constexpr size_t OFF_WIN = OFF_MISC + SZ_MISC;
constexpr size_t OFF_WUP = OFF_WIN + SZ_WIN;
constexpr size_t OFF_WM = OFF_WUP + SZ_WUP;
constexpr size_t OFF_WO = OFF_WM + SZ_WM;
constexpr size_t OFF_DFTL = OFF_WO + SZ_WO;
constexpr size_t OFF_DFTC = OFF_DFTL + SZ_DFTL;
constexpr size_t OFF_HG = OFF_DFTC + SZ_DFTC;
constexpr size_t OFF_QD = OFF_HG, OFF_KD = OFF_QD + 2 * SZ_TOK256, OFF_KDT = OFF_KD + 2 * SZ_TOK256;
constexpr size_t OFF_H = OFF_HG;
constexpr size_t OFF_EV = OFF_KDT + 2 * SZ_VT;
constexpr size_t OFF_ZQK = OFF_EV + SZ_EV;
constexpr size_t OFF_ACC = OFF_ZQK;
constexpr size_t OFF_YG = OFF_ZQK + SZ_TOK1024;
constexpr size_t OFF_VT = OFF_YG + SZ_TOK1024;
constexpr size_t OFF_FBL = OFF_VT + 3 * SZ_VT;
constexpr size_t OFF_FBC = OFF_FBL + SZ_FBL;
constexpr size_t OFF_G = OFF_FBC + SZ_FBC;
constexpr size_t OFF_O32 = OFF_G;
constexpr size_t OFF_CQ = OFF_G + SZ_G;
constexpr size_t OFF_ROPE = OFF_CQ + SZ_TOK256;
constexpr size_t OFF_BAR = OFF_ROPE + (size_t)2048 * 32 * 4;
constexpr size_t OFF_W2 = OFF_BAR + 16384;
constexpr size_t SZ_W = SZ_WIN + SZ_WUP + SZ_WM + SZ_WO;
constexpr size_t OFF_END = OFF_W2 + SZ_W;
static_assert(OFF_WUP == OFF_WIN + SZ_WIN && OFF_WM == OFF_WUP + SZ_WUP && OFF_WO == OFF_WM + SZ_WM, "weight set must be contiguous");
static_assert(OFF_END <= (size_t)536870912, "workspace budget");
constexpr size_t OFF_BRS = OFF_VT, OFF_ACCS = OFF_BRS + SZ_SCR;
constexpr size_t OFF_T4 = OFF_BRS + 33554432;
static_assert(OFF_T4 + 33554432 <= OFF_ACCS, "T4 overlaps the partial-sum stash");
constexpr int XB_SPLITCNT = 3584;
static_assert(OFF_ACCS + SZ_SCR <= OFF_ROPE, "scratch alias overflow");
static_assert(SZ_TOK1024 == 4 * SZ_TOK256, "H alias");

constexpr int MISC_LOGLB = 0;
constexpr int MISC_LOG1M = 2048;
constexpr int MISC_LAM = 4096;
constexpr int MISC_CTR = 4160;

constexpr int LDS_BYTES = 131072 + 4096;
constexpr int LDS_MISC = 131072;

struct KArgs {
    const float *x, *c, *ctx, *c_ctx, *norm_gain, *w_mod, *b_mod, *w_in, *da_qk_gain, *da_lambda, *da_subln_gain, *na_qk_gain, *na_rpb, *hg_lb_logits, *hg_norm_gain, *w_up, *w_merge, *w_out;
    float* out;
    unsigned char* ws;
    int phase_lo, phase_hi;
};
typedef const KArgs __attribute__((address_space(4)))* KPtr;
struct Params { KPtr k; int wvid, pad_; };

DI int ltid(int wvid) { int t; asm volatile("v_mbcnt_lo_u32_b32 %0, -1, 0\n\tv_mbcnt_hi_u32_b32 %0, -1, %0" : "=v"(t)); return wvid * 64 + t; }
DI int lbid() { int b = (int)blockIdx.x; asm volatile("" : "+s"(b)); return b; }
typedef float f32x2v __attribute__((ext_vector_type(2)));
typedef __bf16 bf16x2v __attribute__((ext_vector_type(2)));
DI unsigned short f2bf(float f) { __bf16 b = (__bf16)f; return __builtin_bit_cast(unsigned short, b); }
DI float bf2f(unsigned short b) { return __uint_as_float(((unsigned)b) << 16); }
DI unsigned pack2(float lo, float hi) { f32x2v v = {lo, hi}; bf16x2v r = __builtin_convertvector(v, bf16x2v); return __builtin_bit_cast(unsigned, r); }
DI float bflo(unsigned u) { return __uint_as_float(u << 16); }
DI float bfhi(unsigned u) { return __uint_as_float(u & 0xffff0000u); }
DI u32x2 mku2(unsigned a, unsigned b) { u32x2 r; r.x = a; r.y = b; return r; }
DI bf16x8 mk8(u32x2 a, u32x2 b) { u32x4 u; u.x = a.x; u.y = a.y; u.z = b.x; u.w = b.y; return __builtin_bit_cast(bf16x8, u); }
DI bf16x8 mk8u(u32x4 u) { return __builtin_bit_cast(bf16x8, u); }
DI bf16x8 pack8(float a, float b, float c, float d, float e, float f, float g, float h) { u32x4 u; u.x = pack2(a, b); u.y = pack2(c, d); u.z = pack2(e, f); u.w = pack2(g, h); return __builtin_bit_cast(bf16x8, u); }
DI float siluf(float v) { return v * __builtin_amdgcn_rcpf(1.f + __builtin_amdgcn_exp2f(-1.4426950408889634f * v)); }
DI float sigmoidf_(float v) { return __builtin_amdgcn_rcpf(1.f + __builtin_amdgcn_exp2f(-1.4426950408889634f * v)); }
DI int crow(int i, int h) { return (i & 3) + 8 * (i >> 2) + 4 * h; }
#define MFMA32(a, b, c) __builtin_amdgcn_mfma_f32_32x32x16_bf16((a), (b), (c), 0, 0, 0)
DI f32x16 zero16() { f32x16 z; for (int i = 0; i < 16; ++i) z[i] = 0.f; return z; }
DI const float* xrow_in(const Params& p, int layer, int row) {
    if (layer == 0) return row < TL ? p.k->x + (size_t)row * DM : p.k->ctx + (size_t)(row - TL) * DM;
    return row < TL ? p.k->out + (size_t)row * DM : (const float*)(p.k->ws + OFF_XC) + (size_t)(row - TL) * DM; }
DI size_t wsel(int layer) { return (layer & 1) ? (OFF_W2 - OFF_WIN) : 0; }
DI float* xrow(const Params& p, int row) { return row < TL ? p.k->out + (size_t)row * DM : (float*)(p.k->ws + OFF_XC) + (size_t)(row - TL) * DM; }

#define XB_TMO      128
#define XB_XCNT(j)  (256  + 64 * (j))
#define XB_XSUB(j)  (1280 + 64 * (j))
#define XB_XGEN(j)  (2304 + 64 * (j))
#define XB_TOP      3328
#define XB_TOPGEN   3392
#define XCD_BAR_WORDS 3456
#define XB_SPIN_CAP (1u << 18)
DI unsigned xb_ld(unsigned* p) { return __hip_atomic_load(p, __ATOMIC_RELAXED, __HIP_MEMORY_SCOPE_AGENT); }
DI unsigned xb_add(unsigned* p, unsigned v) { return __hip_atomic_fetch_add(p, v, __ATOMIC_RELAXED, __HIP_MEMORY_SCOPE_AGENT); }
DI unsigned xb_xcc_id() { return (unsigned)__builtin_amdgcn_s_getreg((3 << 11) | 20) & 0xFu; }
#define XB_SPIN(cond, bar) do { unsigned _sp = 0; while (cond) { __builtin_amdgcn_s_sleep(1); \
    if ((++_sp & 255u) == 0u) { if (xb_ld(&(bar)[XB_TMO])) break; if (_sp > XB_SPIN_CAP) { atomicAdd(&(bar)[XB_TMO], 1u); break; } } } } while (0)
struct XcdBarrier { unsigned* bar; unsigned x; volatile LAS unsigned* st; };
DI XcdBarrier xcd_barrier_post(unsigned* bar, volatile LAS unsigned* st, int tid) {
    XcdBarrier b; b.bar = bar; b.x = xb_xcc_id(); b.st = st;
    if (tid == 0) (void)xb_add(&bar[XB_XCNT(b.x)], 1u);
    return b;
}
DI void xcd_barrier_complete(unsigned* bar, unsigned x, unsigned& nloc, unsigned& nx) {
    const unsigned G = gridDim.x;
    unsigned sum, cnt, mine, sp = 0u;
    for (;;) {
        sum = 0u; cnt = 0u; mine = 0u;
#pragma unroll
        for (unsigned j = 0; j < 16; ++j) { const unsigned c = xb_ld(&bar[XB_XCNT(j)]); sum += c; cnt += (c > 0u) ? 1u : 0u; mine = (j == x) ? c : mine; }
        if (sum == G) break;
        __builtin_amdgcn_s_sleep(1);
        if ((++sp & 255u) == 0u) { if (xb_ld(&bar[XB_TMO])) break; if (sp > XB_SPIN_CAP) { atomicAdd(&bar[XB_TMO], 1u); break; } }
    }
    nloc = mine > 0u ? mine : 1u; nx = cnt > 0u ? cnt : 1u;
}
DI void xcd_barrier(const XcdBarrier& b, int tid) {
    asm volatile("s_waitcnt vmcnt(0)" ::: "memory");
    __syncthreads();
    if (tid == 0) {
        unsigned* bar = b.bar;
        __builtin_amdgcn_s_waitcnt(0);
        unsigned nloc = b.st[0], nx = b.st[1];
        if (nloc == 0u) { xcd_barrier_complete(bar, b.x, nloc, nx); b.st[0] = nloc; b.st[1] = nx; }
        const unsigned old = xb_add(&bar[XB_XSUB(b.x)], 1u);
        const unsigned gen = old / nloc;
        if (old + 1u == (gen + 1u) * nloc) {
            __builtin_amdgcn_fence(__ATOMIC_RELEASE, "agent");
            asm volatile("s_waitcnt vmcnt(0)" ::: "memory");
            const unsigned og = xb_add(&bar[XB_TOP], 1u);
            const unsigned tg = og / nx;
            if (og + 1u == (tg + 1u) * nx) xb_add(&bar[XB_TOPGEN], 1u);
            else XB_SPIN(xb_ld(&bar[XB_TOPGEN]) == tg, bar);
            __builtin_amdgcn_fence(__ATOMIC_ACQUIRE, "agent");
            xb_add(&bar[XB_XGEN(b.x)], 1u);
            asm volatile("s_waitcnt vmcnt(0)" ::: "memory");
        } else {
            XB_SPIN(xb_ld(&bar[XB_XGEN(b.x)]) == gen, bar);
            __builtin_amdgcn_fence(__ATOMIC_ACQUIRE, "agent");
            asm volatile("s_waitcnt vmcnt(0)" ::: "memory");
        }
    }
    __syncthreads();
}

constexpr int BM = 256, BK = 64, HALF = 128, HTB = HALF * BK * 2, NXCD = 8, WGM = 8;
DI int lds_byte(int r, int c) { const int st = (r >> 4) * 2 + (c >> 5), rr = r & 15, cc = c & 31, ob = rr * 64 + cc * 2; return st * 1024 + (ob ^ (((ob >> 9) & 1) << 5)); }
DI void stage_rc(int b, int& R, int& C) { const int st = b / 1024, sb = b % 1024, swz = sb ^ (((sb >> 9) & 1) << 5); R = (st >> 1) * 16 + swz / 64; C = (st & 1) * 32 + (swz % 64) / 2; }
DI int perm32(int rho) { const int n = rho >> 4, i = rho & 15; return 8 * (i >> 2) + 4 * n + (i & 3); }

struct GUnit { const char* A; const char* B; int nt, pm, pn, sub; };

DI void tile_order(int L, int nM, int nN, int& pm, int& pn) {
    const int nwg = nM * nN; int wgid = L;
    { const int q = nwg / NXCD, r = nwg % NXCD, xcd = wgid % NXCD, off = wgid / NXCD; wgid = (xcd < r ? xcd * (q + 1) : r * (q + 1) + (xcd - r) * q) + off; }
    const int nig = WGM * nN, gid = wgid / nig, fm = gid * WGM, gsz = (nM - fm) < WGM ? (nM - fm) : WGM;
    pm = fm + ((wgid % nig) % gsz); pn = (wgid % nig) / gsz;
}

template <bool PERM, class Sched, class Epi>
DI void gemm_phase(LAS unsigned char* lds, const int wvid, const int lda, const int ldb, const Sched& S, const Epi& E) {
    const int tid = ltid(wvid), wid = __builtin_amdgcn_readfirstlane(tid >> 6), lane = tid & 63, wr = wid >> 2, wc = wid & 3, fr = lane & 15, fq = lane >> 4;
    unsigned voffA[2], voffB[2];
#pragma unroll
    for (int i = 0; i < 2; ++i) { int R, C; stage_rc(tid * 16 + i * 8192, R, C); const int Rb = PERM ? ((R & ~31) + perm32(R & 31)) : R;
        voffA[i] = (unsigned)(R * lda + C) * 2u; voffB[i] = (unsigned)(Rb * ldb + C) * 2u; }
    const size_t kstep = (size_t)(BK * 2);
    const size_t hstepA = (size_t)HALF * lda * 2, hstepB = (size_t)HALF * ldb * 2;
    const unsigned ldsw = (unsigned)wid * 1024u;
    const int aoff = lds_byte(wr * 64 + fr, fq * 8), boff = lds_byte(wc * 32 + fr, fq * 8);
#define PG8_SA(b, h) (((b) * 2 + (h)) * HTB)
#define PG8_SB(b, h) ((4 + (b) * 2 + (h)) * HTB)
#define PG8_STAGE(bufoff, gbase, voff) do { _Pragma("unroll") for (int _i = 0; _i < 2; ++_i) \
        __builtin_amdgcn_global_load_lds((const unsigned*)((const char*)(gbase) + (voff)[_i]), (LAS unsigned*)(lds + (bufoff) + ldsw + _i * 8192), 16, 0, 0); } while (0)
#define PG8_LDA(dst, b, h) do { _Pragma("unroll") for (int m = 0; m < 4; ++m) _Pragma("unroll") for (int k = 0; k < 2; ++k) dst[m][k] = *(const LAS bf16x8*)(lds + PG8_SA(b, h) + aoff + m * 2048 + k * 1024); } while (0)
#define PG8_LDB(dst, b, h) do { _Pragma("unroll") for (int n = 0; n < 2; ++n) _Pragma("unroll") for (int k = 0; k < 2; ++k) dst[n][k] = *(const LAS bf16x8*)(lds + PG8_SB(b, h) + boff + n * 2048 + k * 1024); } while (0)
#define PG8_MMA(ai, bj, At, Bt) do { __builtin_amdgcn_s_setprio(1); _Pragma("unroll") for (int m = 0; m < 4; ++m) _Pragma("unroll") for (int n = 0; n < 2; ++n) _Pragma("unroll") for (int k = 0; k < 2; ++k) \
        acc[ai][bj][m][n] = __builtin_amdgcn_mfma_f32_16x16x32_bf16(Bt[n][k], At[m][k], acc[ai][bj][m][n], 0, 0, 0); __builtin_amdgcn_s_setprio(0); } while (0)
#define PG8_WAIT_V(n) asm volatile("s_waitcnt vmcnt(" #n ")" ::: "memory")
#define PG8_WAIT_L(n) asm volatile("s_waitcnt lgkmcnt(" #n ")" ::: "memory")
#define PG8_BAR __builtin_amdgcn_s_barrier()
#define PG8_SCHED __builtin_amdgcn_sched_barrier(0)
    GUnit cur, nxt; int ui = 0;
    if (!S.next(0, cur)) return;
    f32x4 acc[2][2][4][2];
#pragma unroll
    for (int a = 0; a < 2; ++a)
#pragma unroll
        for (int b = 0; b < 2; ++b)
#pragma unroll
            for (int m = 0; m < 4; ++m)
#pragma unroll
                for (int n = 0; n < 2; ++n) acc[a][b][m][n] = (f32x4){0.f, 0.f, 0.f, 0.f};
    bf16x8 At[4][2], B0[2][2], B1[2][2];
    const char* cA = cur.A; const char* cB = cur.B;
    asm volatile("" : "+s"(cA), "+s"(cB));
    PG8_STAGE(PG8_SB(0, 0), cB, voffB); PG8_STAGE(PG8_SA(0, 0), cA, voffA); PG8_STAGE(PG8_SB(0, 1), cB + hstepB, voffB); PG8_STAGE(PG8_SA(0, 1), cA + hstepA, voffA);
    if (wr == 1) PG8_BAR;
    PG8_WAIT_V(4); PG8_BAR;
    PG8_STAGE(PG8_SB(1, 0), cB + kstep, voffB); PG8_STAGE(PG8_SA(1, 0), cA + kstep, voffA); PG8_STAGE(PG8_SB(1, 1), cB + hstepB + kstep, voffB);
    PG8_WAIT_V(6); PG8_BAR;
    for (;;) {
        const bool has_next = S.next(ui + 1, nxt);
        const char* nA = has_next ? nxt.A : cA; const char* nB = has_next ? nxt.B : cB;
        asm volatile("" : "+s"(nA), "+s"(nB));
        const int nt = cur.nt;
        for (int t = 0; t < nt; t += 2) {
            const bool last = (t == nt - 2);
            const char* a1 = cA + (size_t)(t + 1) * kstep;
            const char* a2 = last ? nA : cA + (size_t)(t + 2) * kstep; const char* b2 = last ? nB : cB + (size_t)(t + 2) * kstep;
            const char* a3 = a2 + kstep; const char* b3 = b2 + kstep;
            PG8_LDB(B0, 0, 0); PG8_SCHED; PG8_LDA(At, 0, 0); PG8_STAGE(PG8_SA(1, 1), a1 + hstepA, voffA);
            PG8_WAIT_L(8); PG8_BAR; PG8_WAIT_L(0); PG8_MMA(0, 0, At, B0); PG8_BAR; PG8_SCHED;
            PG8_LDB(B1, 0, 1); PG8_STAGE(PG8_SB(0, 0), b2, voffB);
            PG8_BAR; PG8_WAIT_L(0); PG8_MMA(0, 1, At, B1); PG8_BAR;
            PG8_LDA(At, 0, 1); PG8_STAGE(PG8_SA(0, 0), a2, voffA);
            PG8_BAR; PG8_WAIT_L(0); PG8_MMA(1, 0, At, B0); PG8_BAR; PG8_SCHED;
            PG8_STAGE(PG8_SB(0, 1), b2 + hstepB, voffB);
            PG8_WAIT_V(6); PG8_BAR; PG8_MMA(1, 1, At, B1); PG8_BAR;
            PG8_LDB(B0, 1, 0); PG8_SCHED; PG8_LDA(At, 1, 0); PG8_STAGE(PG8_SA(0, 1), a2 + hstepA, voffA);
            PG8_WAIT_L(8); PG8_BAR; PG8_WAIT_L(0); PG8_MMA(0, 0, At, B0); PG8_BAR; PG8_SCHED;
            PG8_LDB(B1, 1, 1); PG8_STAGE(PG8_SB(1, 0), b3, voffB);
            PG8_BAR; PG8_WAIT_L(0); PG8_MMA(0, 1, At, B1); PG8_BAR;
            PG8_LDA(At, 1, 1); PG8_STAGE(PG8_SA(1, 0), a3, voffA);
            PG8_BAR; PG8_WAIT_L(0); PG8_MMA(1, 0, At, B0); PG8_BAR; PG8_SCHED;
            PG8_STAGE(PG8_SB(1, 1), b3 + hstepB, voffB);
            PG8_WAIT_V(6); PG8_BAR; PG8_MMA(1, 1, At, B1); PG8_BAR;
        }
        { const int t2 = ltid(wvid); const int w2 = __builtin_amdgcn_readfirstlane(t2 >> 6);
          E(acc, cur, w2 >> 2, w2 & 3, t2 & 15, (t2 >> 4) & 3); }
        if (!has_next) break;
#pragma unroll
        for (int a = 0; a < 2; ++a)
#pragma unroll
            for (int b = 0; b < 2; ++b)
#pragma unroll
                for (int m = 0; m < 4; ++m)
#pragma unroll
                    for (int n = 0; n < 2; ++n) acc[a][b][m][n] = (f32x4){0.f, 0.f, 0.f, 0.f};
        cur = nxt; cA = nA; cB = nB; ++ui;
    }
    PG8_WAIT_V(0);
    if (wr == 0) PG8_BAR;
    PG8_BAR;
#undef PG8_SA
#undef PG8_SB
#undef PG8_STAGE
#undef PG8_LDA
#undef PG8_LDB
#undef PG8_MMA
#undef PG8_WAIT_V
#undef PG8_WAIT_L
#undef PG8_BAR
#undef PG8_SCHED
}

#define EPI8_BEGIN _Pragma("unroll") for (int ai = 0; ai < 2; ++ai) _Pragma("unroll") for (int m = 0; m < 4; ++m) _Pragma("unroll") for (int bj = 0; bj < 2; ++bj) { \
    const int dr = ai * 128 + m * 16, dc = bj * 128, idx = (ai * 4 + m) * 2 + bj; const f32x4 v0 = acc[ai][bj][m][0], v1 = acc[ai][bj][m][1]; (void)dr; (void)dc; (void)idx;
#define EPI8_END asm volatile("" ::: "memory"); }

struct SchedG1 {
    int nM, nN, G, c; const char* A; const char* B;
    DI bool next(int i, GUnit& u) const {
        const int L = i * G + c; if (L >= nM * nN) return false;
        tile_order(L, nM, nN, u.pm, u.pn); u.sub = 0; u.nt = 16;
        u.A = A + (size_t)u.pm * 256 * 1024 * 2; u.B = B + (size_t)u.pn * 256 * 1024 * 2; return true;
    }
};
struct EpiG1 {
    unsigned char* ws; int layer; const float* qkg; const float* rope;
    DI void operator()(const f32x4 (&acc)[2][2][4][2], const GUnit& u, int wr, int wc, int fr, int fq) const {
        const int rl0 = wr * 64 + fr, col0 = wc * 32 + 8 * fq, pm = u.pm, pn = u.pn;
        const bool lat = pm < 128; const int b = lat ? (pm >> 3) : (pm - 128);
        const int row0 = pm * 256 + rl0;
        if (pn == 7 || pn == 8) {
            float* Gp = (float*)(ws + OFF_G) + (size_t)(pn - 7) * TT * 256 + (size_t)row0 * 256 + col0;
            EPI8_BEGIN { float* d = Gp + (size_t)dr * 256 + dc; *(f32x4*)d = v0; *(f32x4*)(d + 4) = v1; } EPI8_END
        } else if (pn == 2 || pn == 5 || pn == 9 || pn == 10 || pn == 11) {
            bf16_t* base; int ldt, pos;
            if (pn >= 10) { const int part = pn - 10;
                if (lat) { base = (bf16_t*)(ws + OFF_FBL); ldt = 4096; pos = part * 2048 + (pm & 7) * 256 + rl0; }
                else { base = (bf16_t*)(ws + OFF_FBC); ldt = 512; pos = part * 256 + rl0; } }
            else { base = (bf16_t*)(ws + OFF_VT + (size_t)(pn == 2 ? 0 : pn == 5 ? 1 : 2) * SZ_VT); ldt = KEYS; pos = (lat ? (pm & 7) * 256 : SEQ) + rl0; }
            bf16_t* d0 = base + ((size_t)b * 256 + col0) * ldt + pos;
            EPI8_BEGIN { bf16_t* d = d0 + (size_t)dc * ldt + dr;
#pragma unroll
                for (int j = 0; j < 4; ++j) { d[(size_t)j * ldt] = f2bf(v0[j]); d[(size_t)(4 + j) * ldt] = f2bf(v1[j]); } } EPI8_END
        } else {
            bf16_t* d0; int ldn; bool act;
            if (pn == 6) { d0 = (bf16_t*)(ws + OFF_CQ) + col0; ldn = 256; act = true; }
            else if (pn >= 12) { d0 = (bf16_t*)(ws + OFF_YG) + (pn - 12) * 256 + col0; ldn = 1024; act = true; }
            else { d0 = (bf16_t*)(ws + OFF_ZQK) + (pn == 0 ? 0 : pn == 1 ? 256 : pn == 3 ? 512 : 768) + col0; ldn = 1024; act = false; }
            d0 += (size_t)row0 * ldn;
            if (act) { EPI8_BEGIN { u32x4 o; o.x = pack2(siluf(v0[0]), siluf(v0[1])); o.y = pack2(siluf(v0[2]), siluf(v0[3])); o.z = pack2(siluf(v1[0]), siluf(v1[1])); o.w = pack2(siluf(v1[2]), siluf(v1[3]));
                *(u32x4*)(d0 + (size_t)dr * ldn + dc) = o; } EPI8_END }
            else if (pn <= 1) {
                const float* gp = qkg + pn * 32 + 8 * fq; const f32x4 ga = *(const f32x4*)gp, gb = *(const f32x4*)(gp + 4);
                EPI8_BEGIN { float t[8] = {v0[0], v0[1], v0[2], v0[3], v1[0], v1[1], v1[2], v1[3]};
                    float ss = 0.f;
#pragma unroll
                    for (int j = 0; j < 8; ++j) ss += t[j] * t[j];
                    ss += __shfl_xor(ss, 16); ss += __shfl_xor(ss, 32);
                    const float r = rsqrtf(ss * (1.f / 32.f) + EPS);
#pragma unroll
                    for (int j = 0; j < 8; ++j) t[j] *= r * (j < 4 ? ga[j] : gb[j - 4]);
                    if (lat) { const float* rt = rope + (size_t)((row0 + dr) & (SEQ - 1)) * 32 + 8 * (fq & 1);
                        const f32x4 c0 = *(const f32x4*)rt, c1 = *(const f32x4*)(rt + 4), s0 = *(const f32x4*)(rt + 16), s1 = *(const f32x4*)(rt + 20);
#pragma unroll
                        for (int j = 0; j < 8; ++j) { const float other = __shfl_xor(t[j], 32); const float cs = j < 4 ? c0[j] : c1[j - 4], sn = j < 4 ? s0[j] : s1[j - 4];
                            t[j] = (fq & 2) ? (other * sn + t[j] * cs) : (t[j] * cs - other * sn); } }
                    *(u32x4*)(d0 + (size_t)dr * ldn + dc) = __builtin_bit_cast(u32x4, pack8(t[0], t[1], t[2], t[3], t[4], t[5], t[6], t[7])); } EPI8_END }
            else { EPI8_BEGIN { u32x4 o; o.x = pack2(v0[0], v0[1]); o.y = pack2(v0[2], v0[3]); o.z = pack2(v1[0], v1[1]); o.w = pack2(v1[2], v1[3]);
                *(u32x4*)(d0 + (size_t)dr * ldn + dc) = o; } EPI8_END }
        }
    }
};

struct SchedOne { GUnit u; DI bool next(int i, GUnit& o) const { if (i != 0) return false; o = u; return true; } };
struct EpiFour {
    bf16_t* Y; int rowbase;
    DI void operator()(const f32x4 (&acc)[2][2][4][2], const GUnit& u, int wr, int wc, int fr, int fq) const {
        const int r0 = rowbase + u.pm * 256 + wr * 64 + fr, c0 = 768 + wc * 32 + 8 * fq;
#pragma unroll
        for (int g8 = 0; g8 < 2; ++g8) {
            u32x4 gq[8];
#pragma unroll
            for (int q = 0; q < 8; ++q) { const int idx = g8 * 8 + q, ai = idx >> 3, m = (idx >> 1) & 3, bj = idx & 1; gq[q] = *(const u32x4*)(Y + (size_t)(r0 + ai * 128 + m * 16) * 1024 + c0 + bj * 128); }
#pragma unroll
            for (int q = 0; q < 8; ++q) { const int idx = g8 * 8 + q, ai = idx >> 3, m = (idx >> 1) & 3, bj = idx & 1; const f32x4 v0 = acc[ai][bj][m][0], v1 = acc[ai][bj][m][1]; const u32x4 g = gq[q]; u32x4 o;
                o.x = pack2(v0[0] * bflo(g.x), v0[1] * bfhi(g.x)); o.y = pack2(v0[2] * bflo(g.y), v0[3] * bfhi(g.y));
                o.z = pack2(v1[0] * bflo(g.z), v1[1] * bfhi(g.z)); o.w = pack2(v1[2] * bflo(g.w), v1[3] * bfhi(g.w));
                *(u32x4*)(Y + (size_t)(r0 + ai * 128 + m * 16) * 1024 + c0 + bj * 128) = o; }
            asm volatile("" ::: "memory");
        }
    }
};

struct SchedG2 {
    int nM, G, c; const char *YG, *WUP, *H, *WM;
    DI bool next(int i, GUnit& u) const {
        const int sup = i >> 3, sub = i & 7;
        if (sup < 2) {
            const int L = sup * G + c; if (L >= nM * 4) return false;
            tile_order(L, nM, 4, u.pm, u.pn); u.sub = sub; const int br = sub >> 1;
            if (!(sub & 1)) { u.nt = 4; u.A = YG + ((size_t)u.pm * 256 * 1024 + br * 256) * 2; u.B = WUP + ((size_t)u.pn * 256 * 1024 + br * 256) * 2; }
            else { u.nt = 16; u.A = H + (size_t)u.pm * 256 * 1024 * 2; u.B = WM + ((size_t)(br * 1024 + u.pn * 256) * 1024) * 2; }
            return true;
        }
        if (sup > 2 || sub > 1 || nM * 4 <= 2 * G) return false;
        const int L = 2 * G + (c & 63), br = c >> 6; tile_order(L, nM, 4, u.pm, u.pn); u.sub = 8 + sub;
        if (!sub) { u.nt = 4; u.A = YG + ((size_t)u.pm * 256 * 1024 + br * 256) * 2; u.B = WUP + ((size_t)u.pn * 256 * 1024 + br * 256) * 2; }
        else { u.nt = 16; u.A = H + (size_t)u.pm * 256 * 1024 * 2; u.B = WM + ((size_t)(br * 1024 + u.pn * 256) * 1024) * 2; }
        return true;
    }
};
struct EpiG2 {
    u32x4* brs; u32x4* accs; bf16_t* ACC; u32x4* t4;
    DI void operator()(const f32x4 (&acc)[2][2][4][2], const GUnit& u, int wr, int wc, int fr, int fq) const {
        const int tid = (wr * 4 + wc) * 64 + fq * 16 + fr; const int sub = u.sub;
        u32x4* B = brs + tid; u32x4* A = accs + tid;
        if (sub == 9) {
            u32x4* T = t4 + tid;
#pragma unroll
            for (int g8 = 0; g8 < 2; ++g8) {
                u32x4 bq[8];
#pragma unroll
                for (int q = 0; q < 8; ++q) bq[q] = B[(size_t)(g8 * 8 + q) * 512];
#pragma unroll
                for (int q = 0; q < 8; ++q) { const int idx = g8 * 8 + q, ai = idx >> 3, m = (idx >> 1) & 3, bj = idx & 1; const f32x4 v0 = acc[ai][bj][m][0], v1 = acc[ai][bj][m][1]; const u32x4 b = bq[q]; u32x4 o;
                    o.x = pack2(sigmoidf_(v0[0]) * bflo(b.x), sigmoidf_(v0[1]) * bfhi(b.x)); o.y = pack2(sigmoidf_(v0[2]) * bflo(b.y), sigmoidf_(v0[3]) * bfhi(b.y));
                    o.z = pack2(sigmoidf_(v1[0]) * bflo(b.z), sigmoidf_(v1[1]) * bfhi(b.z)); o.w = pack2(sigmoidf_(v1[2]) * bflo(b.w), sigmoidf_(v1[3]) * bfhi(b.w));
                    T[(size_t)idx * 512] = o; }
                asm volatile("" ::: "memory");
            }
        } else if (!(sub & 1)) {
            EPI8_BEGIN { u32x4 o; o.x = pack2(v0[0], v0[1]); o.y = pack2(v0[2], v0[3]); o.z = pack2(v1[0], v1[1]); o.w = pack2(v1[2], v1[3]); B[(size_t)idx * 512] = o; } EPI8_END
        } else {
            const int br = sub >> 1; const int row0 = u.pm * 256 + wr * 64 + fr, col0 = u.pn * 256 + wc * 32 + 8 * fq;
#pragma unroll
            for (int g8 = 0; g8 < 2; ++g8) {
                u32x4 bq[8], aq[8];
#pragma unroll
                for (int q = 0; q < 8; ++q) { bq[q] = B[(size_t)(g8 * 8 + q) * 512]; aq[q] = (u32x4){0u, 0u, 0u, 0u}; }
                if (br > 0) {
#pragma unroll
                    for (int q = 0; q < 8; ++q) aq[q] = A[(size_t)(g8 * 8 + q) * 512];
                }
#pragma unroll
                for (int q = 0; q < 8; ++q) {
                    const int idx = g8 * 8 + q, ai = idx >> 3, m = (idx >> 1) & 3, bj = idx & 1, dr = ai * 128 + m * 16, dc = bj * 128;
                    const f32x4 v0 = acc[ai][bj][m][0], v1 = acc[ai][bj][m][1]; const u32x4 b = bq[q], a = aq[q]; float t[8];
                    t[0] = sigmoidf_(v0[0]) * bflo(b.x) + bflo(a.x); t[1] = sigmoidf_(v0[1]) * bfhi(b.x) + bfhi(a.x); t[2] = sigmoidf_(v0[2]) * bflo(b.y) + bflo(a.y); t[3] = sigmoidf_(v0[3]) * bfhi(b.y) + bfhi(a.y);
                    t[4] = sigmoidf_(v1[0]) * bflo(b.z) + bflo(a.z); t[5] = sigmoidf_(v1[1]) * bfhi(b.z) + bfhi(a.z); t[6] = sigmoidf_(v1[2]) * bflo(b.w) + bflo(a.w); t[7] = sigmoidf_(v1[3]) * bfhi(b.w) + bfhi(a.w);
                    u32x4 o; o.x = pack2(t[0], t[1]); o.y = pack2(t[2], t[3]); o.z = pack2(t[4], t[5]); o.w = pack2(t[6], t[7]);
                    if (br < 3) A[(size_t)idx * 512] = o; else *(u32x4*)(ACC + (size_t)(row0 + dr) * 1024 + col0 + dc) = o;
                }
                asm volatile("" ::: "memory");
            }
        }
    }
};

struct SchedG3 {
    int nM, G, c; const char* A; const char* B;
    DI bool next(int i, GUnit& u) const {
        const int L = i * G + c; if (L >= nM * 4) return false;
        tile_order(L, nM, 4, u.pm, u.pn); u.sub = 0; u.nt = 16;
        u.A = A + (size_t)u.pm * 256 * 1024 * 2; u.B = B + (size_t)u.pn * 256 * 1024 * 2; return true;
    }
};
struct EpiG3 {
    Params p; int layer;
    DI void operator()(const f32x4 (&acc)[2][2][4][2], const GUnit& u, int wr, int wc, int fr, int fq) const {
        const int pm = u.pm; const int bi = pm < 128 ? (pm >> 3) : 16;
        const float* gate = (const float*)(p.k->ws + OFF_MOD) + ((size_t)layer * 17 + bi) * 3072 + 2048;
        const int row0 = pm * 256 + wr * 64 + fr, col0 = u.pn * 256 + wc * 32 + 8 * fq;
#pragma unroll
        for (int bj = 0; bj < 2; ++bj) { const int cc = col0 + bj * 128; const f32x4 g0 = *(const f32x4*)(gate + cc), g1 = *(const f32x4*)(gate + cc + 4);
            f32x4 x0[8], x1[8];
#pragma unroll
            for (int q = 0; q < 8; ++q) { const float* xi = xrow_in(p, layer, row0 + (q >> 2) * 128 + (q & 3) * 16) + cc; x0[q] = *(const f32x4*)xi; x1[q] = *(const f32x4*)(xi + 4); }
#pragma unroll
            for (int q = 0; q < 8; ++q) { float* xo = xrow(p, row0 + (q >> 2) * 128 + (q & 3) * 16) + cc;
                *(f32x4*)xo = x0[q] + g0 * acc[q >> 2][bj][q & 3][0]; *(f32x4*)(xo + 4) = x1[q] + g1 * acc[q >> 2][bj][q & 3][1]; }
            asm volatile("" ::: "memory"); }
    }
};

constexpr int KS_STRIDE = 144, VS_STRIDE = 136, KS_BYTES = 64 * KS_STRIDE, VS_BYTES = 64 * VS_STRIDE;
constexpr int LDS_KS = 0, LDS_VS = 2 * KS_BYTES, LDS_TB = LDS_VS + 2 * VS_BYTES;

template <bool SCALED>
DI void softmax16(f32x16& x, const float c, float& m, float& l, float& alpha, bf16x8& p0, bf16x8& p1) {
    float mx = x[0];
#pragma unroll
    for (int i = 1; i < 16; ++i) mx = fmaxf(mx, x[i]);
    mx = fmaxf(mx, __shfl_xor(mx, 32));
    const float mc = SCALED ? mx : mx * c;
    const float mn = (mc > m + 8.f) ? mc : m; alpha = __builtin_amdgcn_exp2f(m - mn); m = mn;
    float s = 0.f;
#pragma unroll
    for (int i = 0; i < 16; ++i) { x[i] = __builtin_amdgcn_exp2f(SCALED ? x[i] - mn : __builtin_fmaf(x[i], c, -mn)); s += x[i]; }
    l = l * alpha + s;
    p0 = pack8(x[0], x[1], x[2], x[3], x[4], x[5], x[6], x[7]); p1 = pack8(x[8], x[9], x[10], x[11], x[12], x[13], x[14], x[15]);
}

template <int MODE>
DI void attn_unit(LAS unsigned char* lds, const Params& p, int layer, int b, int h, int kind, int qrow0, int R) {
    const int tid = ltid(p.wvid), wv = tid >> 6, lane = tid & 63, l32 = lane & 31, hh = lane >> 5;
    const bf16_t* Z = (const bf16_t*)(p.k->ws + OFF_ZQK);
    const bf16_t* VT = (const bf16_t*)(p.k->ws + OFF_VT + (MODE == 0 ? 0 : SZ_VT)) + ((size_t)b * 256 + h * 64) * KEYS;
    bf16_t* Y = (bf16_t*)(p.k->ws + OFF_YG);
    const int qcol = (MODE == 0 ? 0 : 512) + h * 64, kcol = qcol + 256, ycol = (MODE == 0 ? 0 : 256) + h * 64;
    int lo = 0, ntile;
    if (kind == 0) ntile = 36; else if (kind == 1) ntile = 4;
    else { lo = min(max(4 * R - 4, 0), 24); const int hi = min(max(4 * R - 1, 0), 24) + 7; ntile = 4 + hi - lo + 1; }
    const float c = (MODE == 0 ? 0.17677669529663687f : 0.125f) * LOG2E;
    const int nrp = wv >> 2, ng = wv & 3, rq = 4 * R + 2 * nrp + (l32 >> 4), cq = 16 * ng + (l32 & 15);
    const int r0w = min(max(rq - 4, 0), 24), c0w = min(max(cq - 8, 0), 48);
    const int r0a = min(max(4 * R + 2 * nrp - 4, 0), 24), r0b = min(max(4 * R + 2 * nrp - 3, 0), 24);
    const int cs = ng == 0 ? 0 : ng == 1 ? 8 : ng == 2 ? 24 : 32;
    const bool na = (MODE == 1 && kind == 2);
    const int qtok = na ? b * SEQ + rq * 64 + cq : qrow0 + wv * 32 + l32;
    __syncthreads();
    if (MODE == 1 && kind == 2) { const float* rp = p.k->na_rpb + ((size_t)layer * 4 + h) * 15 * 31; for (int i = tid; i < 15 * 31; i += 512) *(LAS float*)(lds + LDS_TB + i * 4) = rp[i] * LOG2E; }
    bf16x8 qf[4];
    { const bf16_t* qp = Z + (size_t)qtok * 1024 + qcol + 8 * hh;
#pragma unroll
      for (int s = 0; s < 4; ++s) qf[s] = mk8u(*(const u32x4*)(qp + 16 * s)); }
    auto tile_src = [&](int t, const bf16_t*& kp, const bf16_t*& vp, int& mrow) {
        int krow, key; mrow = -1;
        if (kind == 0) { key = 64 * t; krow = t < 32 ? b * SEQ + 64 * t : TL + b * CTX + 64 * (t - 32); }
        else if (kind == 1 || t < 4) { key = SEQ + 64 * t; krow = TL + b * CTX + 64 * t; }
        else { mrow = lo + t - 4; key = 64 * mrow; krow = b * SEQ + key; }
        kp = Z + (size_t)krow * 1024 + kcol; vp = VT + key;
    };
    const int lr = tid >> 3, lc = tid & 7;
    u32x4 kreg, vreg; const bf16_t *kp, *vp; int mrow;
    tile_src(0, kp, vp, mrow);
    kreg = *(const u32x4*)(kp + (size_t)lr * 1024 + lc * 8); vreg = *(const u32x4*)(vp + (size_t)lr * KEYS + lc * 8);
    *(LAS u32x4*)(lds + LDS_KS + lr * KS_STRIDE + lc * 16) = kreg;
    { LAS u32x2* d = (LAS u32x2*)(lds + LDS_VS + lr * VS_STRIDE + lc * 16); d[0] = mku2(vreg.x, vreg.y); d[1] = mku2(vreg.z, vreg.w); }
    __syncthreads();
    f32x16 O1[2], O2[2]; O1[0] = zero16(); O1[1] = zero16(); O2[0] = zero16(); O2[1] = zero16();
    float m1 = -1e30f, l1 = 0.f, m2 = -1e30f, l2 = 0.f;
    for (int t = 0; t < ntile; ++t) {
        const int buf = t & 1; int mr_cur = mrow;
        if (t + 1 < ntile) { tile_src(t + 1, kp, vp, mrow); kreg = *(const u32x4*)(kp + (size_t)lr * 1024 + lc * 8); vreg = *(const u32x4*)(vp + (size_t)lr * KEYS + lc * 8); }
        bool active = true;
        if (MODE == 1 && mr_cur >= 0) active = (mr_cur >= r0a) && (mr_cur < r0b + 8);
        const int nkt = (MODE == 1 && mr_cur >= 0) ? 1 : 2;
        if (active) {
#pragma nounroll
            for (int kt = 0; kt < nkt; ++kt) {
                const int koff = (MODE == 1 && mr_cur >= 0) ? cs : kt * 32;
                bf16x8 kf[4];
                { const LAS unsigned char* kb = lds + LDS_KS + buf * KS_BYTES + (koff + l32) * KS_STRIDE + 16 * hh;
#pragma unroll
                  for (int s = 0; s < 4; ++s) kf[s] = *(const LAS bf16x8*)(kb + 32 * s); }
                bf16x8 vf[2][2];
#pragma unroll
                for (int mt = 0; mt < 2; ++mt)
#pragma unroll
                    for (int sp = 0; sp < 2; ++sp) { const LAS unsigned char* vb = lds + LDS_VS + buf * VS_BYTES + (mt * 32 + l32) * VS_STRIDE + (koff + 16 * sp + 4 * hh) * 2;
                        vf[mt][sp] = mk8(*(const LAS u32x2*)vb, *(const LAS u32x2*)(vb + 16)); }
                if (MODE == 0) {
                    f32x16 s1 = MFMA32(kf[0], qf[0], zero16()); s1 = MFMA32(kf[1], qf[1], s1);
                    f32x16 s2 = MFMA32(kf[2], qf[2], zero16()); s2 = MFMA32(kf[3], qf[3], s2);
                    float a1, a2; bf16x8 p1[2], p2[2];
                    softmax16<false>(s1, c, m1, l1, a1, p1[0], p1[1]); softmax16<false>(s2, c, m2, l2, a2, p2[0], p2[1]);
                    const bool resc = __any((a1 != 1.f) || (a2 != 1.f));
#pragma unroll
                    for (int mt = 0; mt < 2; ++mt) {
                        if (resc) {
#pragma unroll
                            for (int i = 0; i < 16; ++i) { O1[mt][i] *= a1; O2[mt][i] *= a2; }
                        }
#pragma unroll
                        for (int sp = 0; sp < 2; ++sp) { O1[mt] = MFMA32(vf[mt][sp], p1[sp], O1[mt]); O2[mt] = MFMA32(vf[mt][sp], p2[sp], O2[mt]); }
                    }
                } else {
                    f32x16 s1 = MFMA32(kf[0], qf[0], zero16()); s1 = MFMA32(kf[1], qf[1], s1); s1 = MFMA32(kf[2], qf[2], s1); s1 = MFMA32(kf[3], qf[3], s1);
                    if (mr_cur >= 0) {
                        const int brow = min(max(mr_cur - rq + 7, 0), 14) * 31; const bool rv = (mr_cur >= r0w) && (mr_cur < r0w + 8);
#pragma unroll
                        for (int i = 0; i < 16; ++i) { const int kc = koff + crow(i, hh); const bool in = rv && (kc >= c0w) && (kc < c0w + 16);
                            const int bi = brow + min(max(kc - cq, -15), 15) + 15;
                            const float bv = *(const LAS float*)(lds + LDS_TB + bi * 4);
                            s1[i] = in ? s1[i] * c + bv : -1e30f; }
                    }
                    float a1; bf16x8 p1[2];
                    if (mr_cur >= 0) softmax16<true>(s1, c, m1, l1, a1, p1[0], p1[1]); else softmax16<false>(s1, c, m1, l1, a1, p1[0], p1[1]);
                    const bool resc = __any(a1 != 1.f);
#pragma unroll
                    for (int mt = 0; mt < 2; ++mt) {
                        if (resc) {
#pragma unroll
                            for (int i = 0; i < 16; ++i) O1[mt][i] *= a1;
                        }
#pragma unroll
                        for (int sp = 0; sp < 2; ++sp) O1[mt] = MFMA32(vf[mt][sp], p1[sp], O1[mt]);
                    }
                }
            }
        }
        if (t + 1 < ntile) {
            const int nb = buf ^ 1;
            *(LAS u32x4*)(lds + LDS_KS + nb * KS_BYTES + lr * KS_STRIDE + lc * 16) = kreg;
            LAS u32x2* d = (LAS u32x2*)(lds + LDS_VS + nb * VS_BYTES + lr * VS_STRIDE + lc * 16); d[0] = mku2(vreg.x, vreg.y); d[1] = mku2(vreg.z, vreg.w);
        }
        __syncthreads();
    }
    const float i1 = 1.f / (l1 + __shfl_xor(l1, 32));
    float post = 1.f; const float* gain = nullptr; float lam = 0.f, i2 = 0.f;
    if (MODE == 0) { i2 = 1.f / (l2 + __shfl_xor(l2, 32)); lam = ((const float*)(p.k->ws + OFF_MISC))[MISC_LAM + layer];
        const float lam_init = 0.8f - 0.6f * __expf(-0.3f * (float)layer); post = 1.f - lam_init; gain = p.k->da_subln_gain + layer * 64; }
    float ss = 0.f;
#pragma unroll
    for (int mt = 0; mt < 2; ++mt)
#pragma unroll
        for (int i = 0; i < 16; ++i) { float o = O1[mt][i] * i1; if (MODE == 0) o -= lam * O2[mt][i] * i2; O1[mt][i] = o; ss += o * o; }
    float rn = 1.f;
    if (MODE == 0) { ss += __shfl_xor(ss, 32); rn = rsqrtf(ss * (1.f / 64.f) + EPS) * post; }
    bf16_t* yr = Y + (size_t)qtok * 1024 + ycol;
#pragma unroll
    for (int mt = 0; mt < 2; ++mt)
#pragma unroll
        for (int g = 0; g < 4; ++g) { const int dv = 32 * mt + 8 * g + 4 * hh; u32x2* d = (u32x2*)(yr + dv); const u32x2 sg = *d;
            float o0 = O1[mt][4 * g] * rn, o1 = O1[mt][4 * g + 1] * rn, o2 = O1[mt][4 * g + 2] * rn, o3 = O1[mt][4 * g + 3] * rn;
            if (MODE == 0) { const f32x4 gv = *(const f32x4*)(gain + dv); o0 *= gv[0]; o1 *= gv[1]; o2 *= gv[2]; o3 *= gv[3]; }
            u32x2 o; o.x = pack2(o0 * bflo(sg.x), o1 * bfhi(sg.x)); o.y = pack2(o2 * bflo(sg.y), o3 * bfhi(sg.y)); *d = o; }
}

constexpr int HG_STRIDE = 136, HG_TILE = 64 * HG_STRIDE, HG_ITEM = 4 * HG_TILE, HG_EV = 2 * HG_ITEM;
DI void hgrn_item(LAS unsigned char* lds, const Params& p, int item, int islot, int wq, int lane) {
    const int b = item >> 3, h = (item >> 1) & 3, dir = item & 1, tt = wq >> 1, et = wq & 1, l32 = lane & 31, hh = lane >> 5;
    unsigned* QK = (unsigned*)(p.k->ws + OFF_G) + (size_t)dir * TT * 256 + h * 64;
    const bf16_t* KLT = (const bf16_t*)(p.k->ws + OFF_KDT) + (((size_t)dir * NB + b) * 256 + h * 64) * KEYS;
    const bf16_t* VIT = (const bf16_t*)(p.k->ws + OFF_VT + 2 * SZ_VT) + ((size_t)b * 256 + h * 64) * KEYS;
    const float* EVB = (const float*)(p.k->ws + OFF_EV) + ((size_t)dir * NB + b) * NSLOT * 3 * 256 + h * 64;
    LAS unsigned char* tl = lds + islot * HG_ITEM;
    LAS float* evl = (LAS float*)(lds + HG_EV + islot * (NSLOT * 128 * 4));
    const int t256 = wq * 64 + lane, lrow = t256 >> 3, lc = t256 & 7;
    auto chunk_pos = [&](int j, int& row0, int& kbase) {
        if (j < 4) { const int jj = dir ? 3 - j : j; row0 = TL + b * CTX + 64 * jj; kbase = SEQ + 64 * jj; }
        else { const int jj = dir ? 31 - (j - 4) : j - 4; row0 = b * SEQ + 64 * jj; kbase = 64 * jj; } };
    u32x4 pre[4][2];
    auto issue = [&](int j) { int row0, kbase; chunk_pos(j, row0, kbase);
#pragma unroll
        for (int ps = 0; ps < 2; ++ps) { const int r = lrow + 32 * ps;
            pre[0][ps] = *(const u32x4*)(QK + (size_t)(row0 + r) * 256 + lc * 4); pre[1][ps] = *(const u32x4*)(QK + (size_t)(row0 + r) * 256 + 32 + lc * 4);
            pre[2][ps] = *(const u32x4*)(KLT + (size_t)r * KEYS + kbase + lc * 8); pre[3][ps] = *(const u32x4*)(VIT + (size_t)r * KEYS + kbase + lc * 8); } };
    auto commit = [&]() {
#pragma unroll
        for (int ps = 0; ps < 2; ++ps) { const int r = lrow + 32 * ps;
#pragma unroll
            for (int k = 0; k < 2; ++k) { const u32x4 x = pre[k][ps];
                const unsigned q01 = (x.x & 0xffffu) | (x.y << 16), q23 = (x.z & 0xffffu) | (x.w << 16), k01 = (x.x >> 16) | (x.y & 0xffff0000u), k23 = (x.z >> 16) | (x.w & 0xffff0000u);
                *(LAS u32x2*)(tl + 0 * HG_TILE + r * HG_STRIDE + (32 * k + 4 * lc) * 2) = mku2(q01, q23);
                *(LAS u32x2*)(tl + 1 * HG_TILE + r * HG_STRIDE + (32 * k + 4 * lc) * 2) = mku2(k01, k23); }
#pragma unroll
            for (int t = 2; t < 4; ++t) { LAS u32x2* d = (LAS u32x2*)(tl + t * HG_TILE + r * HG_STRIDE + lc * 16); d[0] = mku2(pre[t][ps].x, pre[t][ps].y); d[1] = mku2(pre[t][ps].z, pre[t][ps].w); } } };
    __syncthreads();
    for (int i = t256; i < NSLOT * 128; i += 256) { const int sl = i >> 7, r = i & 127; evl[i] = EVB[(size_t)sl * 3 * 256 + (r >> 6) * 256 + (r & 63)]; }
    issue(0); commit();
    __syncthreads();
    f32x16 S[2]; S[0] = zero16(); S[1] = zero16();
    auto frag = [&](int tile, int row, int col) { const LAS unsigned char* a = tl + tile * HG_TILE + row * HG_STRIDE + (col + 4 * hh) * 2; return mk8(*(const LAS u32x2*)a, *(const LAS u32x2*)(a + 16)); };
    for (int j = 0; j < NSLOT; ++j) {
        int row0, kbase; chunk_pos(j, row0, kbase);
        if (j + 1 < NSLOT) issue(j + 1);
        const LAS float* ev = evl + (kbase >> 6) * 128 + 4 * hh;
        bf16x8 qp[2][2], vp[2][2];
#pragma unroll
        for (int dt = 0; dt < 2; ++dt)
#pragma unroll
            for (int sp = 0; sp < 2; ++sp) { qp[dt][sp] = frag(0, 32 * tt + l32, 32 * dt + 16 * sp); vp[dt][sp] = frag(3, 32 * et + l32, 32 * dt + 16 * sp); }
        f32x16 o = zero16();
        const int tau = 32 * tt + l32;
#pragma unroll
        for (int st = 0; st < 2; ++st) {
            f32x16 a = zero16();
#pragma unroll
            for (int dt = 0; dt < 2; ++dt)
#pragma unroll
                for (int sp = 0; sp < 2; ++sp) a = MFMA32(frag(1, 32 * st + l32, 32 * dt + 16 * sp), qp[dt][sp], a);
#pragma unroll
            for (int i = 0; i < 16; ++i) { const int sg = 32 * st + crow(i, hh); const bool keep = dir == 0 ? (sg <= tau) : (sg >= tau); a[i] = keep ? a[i] : 0.f; }
#pragma unroll
            for (int sp = 0; sp < 2; ++sp)
                o = MFMA32(pack8(a[8 * sp], a[8 * sp + 1], a[8 * sp + 2], a[8 * sp + 3], a[8 * sp + 4], a[8 * sp + 5], a[8 * sp + 6], a[8 * sp + 7]), vp[st][sp], o);
        }
#pragma unroll
        for (int dt = 0; dt < 2; ++dt) {
            float em[16];
#pragma unroll
            for (int g = 0; g < 4; ++g) { const f32x4 e4 = *(const LAS f32x4*)(ev + 64 + 32 * dt + 8 * g); em[4 * g] = e4[0]; em[4 * g + 1] = e4[1]; em[4 * g + 2] = e4[2]; em[4 * g + 3] = e4[3]; }
#pragma unroll
            for (int sp = 0; sp < 2; ++sp)
                o = MFMA32(qp[dt][sp], pack8(S[dt][8 * sp] * em[8 * sp], S[dt][8 * sp + 1] * em[8 * sp + 1], S[dt][8 * sp + 2] * em[8 * sp + 2], S[dt][8 * sp + 3] * em[8 * sp + 3],
                                             S[dt][8 * sp + 4] * em[8 * sp + 4], S[dt][8 * sp + 5] * em[8 * sp + 5], S[dt][8 * sp + 6] * em[8 * sp + 6], S[dt][8 * sp + 7] * em[8 * sp + 7]), o);
        }
#pragma unroll
        for (int i = 0; i < 16; ++i) ((bf16_t*)(QK + (size_t)(row0 + 32 * tt + crow(i, hh)) * 256 + 32 * et + l32))[0] = f2bf(o[i]);
#pragma unroll
        for (int dt = 0; dt < 2; ++dt) {
            f32x16 tmp = zero16();
#pragma unroll
            for (int st = 0; st < 2; ++st)
#pragma unroll
                for (int sp = 0; sp < 2; ++sp) tmp = MFMA32(frag(2, 32 * dt + l32, 32 * st + 16 * sp), vp[st][sp], tmp);
#pragma unroll
            for (int g = 0; g < 4; ++g) { const f32x4 eb = *(const LAS f32x4*)(ev + 32 * dt + 8 * g);
#pragma unroll
                for (int jj = 0; jj < 4; ++jj) S[dt][4 * g + jj] = eb[jj] * S[dt][4 * g + jj] + tmp[4 * g + jj]; }
        }
        __syncthreads();
        if (j + 1 < NSLOT) commit();
        __syncthreads();
    }
}

DI void phase_h(const Params& p, int layer) {
    const int lane = ltid(p.wvid) & 63, wv = ltid(p.wvid) >> 6;
    bf16_t* H = (bf16_t*)(p.k->ws + OFF_H); const float* ng = p.k->norm_gain + layer * DM;
    const int stride = gridDim.x * 8;
    for (int rowa = lbid() * 8 + wv; rowa < TT; rowa += 2 * stride) {
        f32x4 v[2][4];
#pragma unroll
        for (int r2 = 0; r2 < 2; ++r2) { const int row = rowa + r2 * stride; if (row < TT) { const float* xr = xrow_in(p, layer, row);
#pragma unroll
            for (int k = 0; k < 4; ++k) v[r2][k] = *(const f32x4*)(xr + k * 256 + lane * 4); } }
#pragma unroll
        for (int r2 = 0; r2 < 2; ++r2) { const int row = rowa + r2 * stride; if (row < TT) {
            const int bi = row < TL ? row / SEQ : 16;
            const float* mod = (const float*)(p.k->ws + OFF_MOD) + ((size_t)layer * 17 + bi) * 3072;
            float ss = 0.f;
#pragma unroll
            for (int k = 0; k < 4; ++k) ss += v[r2][k][0] * v[r2][k][0] + v[r2][k][1] * v[r2][k][1] + v[r2][k][2] * v[r2][k][2] + v[r2][k][3] * v[r2][k][3];
#pragma unroll
            for (int o = 32; o > 0; o >>= 1) ss += __shfl_xor(ss, o);
            const float r = rsqrtf(ss * (1.f / DM) + EPS);
#pragma unroll
            for (int k = 0; k < 4; ++k) { const int cc = k * 256 + lane * 4; const f32x4 g = *(const f32x4*)(ng + cc), sh = *(const f32x4*)(mod + cc), sc = *(const f32x4*)(mod + 1024 + cc);
                float o[4];
#pragma unroll
                for (int j = 0; j < 4; ++j) o[j] = v[r2][k][j] * r * g[j] * (1.f + sc[j]) + sh[j];
                u32x2 w; w.x = pack2(o[0], o[1]); w.y = pack2(o[2], o[3]); *(u32x2*)(H + (size_t)row * 1024 + cc) = w; } } }
    }
}

DI void tconv_tile(LAS unsigned char* lds, const int wvid, const float* src, int lds_src, bf16_t* dst, int ldd) {
    LAS float* t = (LAS float*)lds; const int tid = ltid(wvid);
    __syncthreads();
    { const int r = tid >> 4, c4 = (tid & 15) * 4;
#pragma unroll
      for (int rr = 0; rr < 2; ++rr) { const f32x4 v = *(const f32x4*)(src + (size_t)(r + 32 * rr) * lds_src + c4);
#pragma unroll
          for (int j = 0; j < 4; ++j) t[(r + 32 * rr) * 65 + c4 + j] = v[j]; } }
    __syncthreads();
    { const int n = tid >> 3, k0 = (tid & 7) * 8; u32x4 o;
      o.x = pack2(t[(k0) * 65 + n], t[(k0 + 1) * 65 + n]); o.y = pack2(t[(k0 + 2) * 65 + n], t[(k0 + 3) * 65 + n]);
      o.z = pack2(t[(k0 + 4) * 65 + n], t[(k0 + 5) * 65 + n]); o.w = pack2(t[(k0 + 6) * 65 + n], t[(k0 + 7) * 65 + n]);
      *(u32x4*)(dst + (size_t)n * ldd + k0) = o; }
}

DI void phase_weights(LAS unsigned char* lds, const Params& p, int layer, int jstart, int jstep) {
    unsigned char* wb = p.k->ws + wsel(layer);
    bf16_t* WIN = (bf16_t*)(wb + OFF_WIN); bf16_t* WUP = (bf16_t*)(wb + OFF_WUP); bf16_t* WM = (bf16_t*)(wb + OFF_WM); bf16_t* WO = (bf16_t*)(wb + OFF_WO);
    const float* win = p.k->w_in + (size_t)layer * 1024 * 3840; const float* wup = p.k->w_up + (size_t)layer * 4 * 256 * 1024;
    const float* wm = p.k->w_merge + (size_t)layer * 4 * 1024 * 1024; const float* wo = p.k->w_out + (size_t)layer * 1024 * 1024;
    constexpr int J_IN = 16 * 56, J_UP = 4 * 4 * 16, J_M = 4 * 16 * 16, J_O = 16 * 16, J_F = 64;
    constexpr int NJ = J_IN + J_UP + J_M + J_O + J_F;
    for (int job = jstart; job < NJ; job += jstep) {
        int j = job;
        if (j < J_IN) { const int kt = j / 56; int nt = j % 56; if (nt >= 40) nt += 4; const int n0 = nt * 64; const int dn = n0 < 2560 ? n0 : n0 + 256;
            tconv_tile(lds, p.wvid, win + (size_t)kt * 64 * 3840 + n0, 3840, WIN + (size_t)dn * 1024 + kt * 64, 1024); continue; }
        j -= J_IN;
        if (j < J_UP) { const int i = j / 64, kt = (j % 64) / 16, nt = j % 16;
            tconv_tile(lds, p.wvid, wup + (size_t)i * 256 * 1024 + (size_t)kt * 64 * 1024 + nt * 64, 1024, WUP + (size_t)nt * 64 * 1024 + i * 256 + kt * 64, 1024); continue; }
        j -= J_UP;
        if (j < J_M) { const int i = j / 256, kt = (j % 256) / 16, nt = j % 16;
            tconv_tile(lds, p.wvid, wm + (size_t)i * 1024 * 1024 + (size_t)kt * 64 * 1024 + nt * 64, 1024, WM + ((size_t)i * 1024 + nt * 64) * 1024 + kt * 64, 1024); continue; }
        j -= J_M;
        if (j < J_O) { const int kt = j / 16, nt = j % 16; tconv_tile(lds, p.wvid, wo + (size_t)kt * 64 * 1024 + nt * 64, 1024, WO + (size_t)nt * 64 * 1024 + kt * 64, 1024); continue; }
        j -= J_O;
        {
            const int kt = j >> 2, g = j & 3; LAS float* t = (LAS float*)lds; LAS float* cs = t + 64 * 65; const int tid = ltid(p.wvid);
            __syncthreads();
            { const int r = tid >> 4, c4 = (tid & 15) * 4;
#pragma unroll
              for (int rr = 0; rr < 2; ++rr) { const f32x4 v = *(const f32x4*)(win + (size_t)(kt * 64 + r + 32 * rr) * 3840 + 2560 + g * 64 + c4);
#pragma unroll
                  for (int jj = 0; jj < 4; ++jj) t[(r + 32 * rr) * 65 + c4 + jj] = v[jj]; } }
            if (tid < 64) { cs[tid] = cospif((float)tid * (1.f / 32.f)) * 0.125f; cs[64 + tid] = sinpif((float)tid * (1.f / 32.f)) * 0.125f; }
            __syncthreads();
            const int cp = tid & 63, kg = tid >> 6; float ac[8], as[8];
#pragma unroll
            for (int k = 0; k < 8; ++k) { ac[k] = 0.f; as[k] = 0.f; }
            for (int cch = 0; cch < 64; ++cch) { const int a = (cch * cp) & 63; const float cv = cs[a], sv = cs[64 + a];
#pragma unroll
                for (int k = 0; k < 8; ++k) { const float w = t[(kg * 8 + k) * 65 + cch]; ac[k] += w * cv; as[k] += w * sv; } }
            u32x4 o; o.x = pack2(ac[0], ac[1]); o.y = pack2(ac[2], ac[3]); o.z = pack2(ac[4], ac[5]); o.w = pack2(ac[6], ac[7]);
            *(u32x4*)(WIN + (size_t)(2560 + g * 64 + cp) * 1024 + kt * 64 + kg * 8) = o;
            o.x = pack2(as[0], as[1]); o.y = pack2(as[2], as[3]); o.z = pack2(as[4], as[5]); o.w = pack2(as[6], as[7]);
            *(u32x4*)(WIN + (size_t)(2816 + g * 64 + cp) * 1024 + kt * 64 + kg * 8) = o;
        }
    }
}

DI void phase_pro(LAS unsigned char* lds, const Params& p) {
    const int tid = ltid(p.wvid); const size_t gt = (size_t)lbid() * 512 + tid, gs = (size_t)gridDim.x * 512;
    float* misc = (float*)(p.k->ws + OFF_MISC);
    if (lbid() == 0) {
        { const int dir = tid >> 8, ch = tid & 255; float lg[4], mx = -1e30f;
          for (int l = 0; l < 4; ++l) { lg[l] = p.k->hg_lb_logits[(dir * 4 + l) * 256 + ch]; mx = fmaxf(mx, lg[l]); }
          float s = 0.f; for (int l = 0; l < 4; ++l) { lg[l] = expf(lg[l] - mx); s += lg[l]; }
          float cum = 0.f;
          for (int l = 0; l < 4; ++l) { if (l > 0) cum += lg[l] / s; const float lb = cum;
              misc[MISC_LOGLB + (dir * 4 + l) * 256 + ch] = logf(fmaxf(lb, 1e-20f)); misc[MISC_LOG1M + (dir * 4 + l) * 256 + ch] = log1pf(-lb); } }
        if (tid < 4) { const float* lv = p.k->da_lambda + tid * 4 * 32; float s0 = 0.f, s1 = 0.f; for (int i = 0; i < 32; ++i) { s0 += lv[i] * lv[32 + i]; s1 += lv[64 + i] * lv[96 + i]; }
            misc[MISC_LAM + tid] = expf(s0) - expf(s1) + (0.8f - 0.6f * expf(-0.3f * (float)tid)); }
        if (tid < 8) ((int*)misc)[MISC_CTR + tid] = 0;
    }
    { float* rp = (float*)(p.k->ws + OFF_ROPE);
      for (size_t i = gt; i < (size_t)2048 * 16; i += gs) { const int n = (int)(i >> 4), j = (int)(i & 15); const float inv = exp2f(-(float)(j & 7) * 1.6609640474436813f);
          const float ang = (float)(j < 8 ? (n >> 6) : (n & 63)) * inv; float sn, cs; sincosf(ang, &sn, &cs); rp[n * 32 + j] = cs; rp[n * 32 + 16 + j] = sn; } }
    { bf16_t* AL = (bf16_t*)(p.k->ws + OFF_DFTL); const float sl = 0.022097086912079608f;
      for (size_t i = gt; i < (size_t)2048 * 4096 / 8; i += gs) { const int n = (int)(i >> 9), k0 = (int)(i & 511) * 8; float v[8];
#pragma unroll
          for (int j = 0; j < 8; ++j) { const int kk = k0 + j; const int k = kk & 2047; const int r = (n * k) & 2047; const float a = (float)r * (1.f / 1024.f); v[j] = (kk < 2048 ? cospif(a) : -sinpif(a)) * sl; }
          *(u32x4*)(AL + i * 8) = __builtin_bit_cast(u32x4, pack8(v[0], v[1], v[2], v[3], v[4], v[5], v[6], v[7])); }
      bf16_t* AC = (bf16_t*)(p.k->ws + OFF_DFTC);
      for (size_t i = gt; i < (size_t)256 * 512 / 8; i += gs) { const int n = (int)(i >> 6), k0 = (int)(i & 63) * 8; float v[8];
#pragma unroll
          for (int j = 0; j < 8; ++j) { const int kk = k0 + j; const int k = kk & 255; const int r = (n * k) & 255; const float a = (float)r * (1.f / 128.f); v[j] = (kk < 256 ? cospif(a) : -sinpif(a)) * 0.0625f; }
          *(u32x4*)(AC + i * 8) = __builtin_bit_cast(u32x4, pack8(v[0], v[1], v[2], v[3], v[4], v[5], v[6], v[7])); } }
    { LAS float* sc = (LAS float*)lds;
      LAS float* red = sc + 17 * 1024;
      __syncthreads();
      for (int i = tid; i < 17 * 1024; i += 512) { const int r = i >> 10, k = i & 1023; const float v = r < 16 ? p.k->c[r * 1024 + k] : p.k->c_ctx[k]; sc[i] = v / (1.f + expf(-v)); }
      __syncthreads();
      const int wv = tid >> 6, lane = tid & 63;
      for (int job = lbid(); job < 4 * 48; job += gridDim.x) {
          const int l = job / 48, col = (job % 48) * 64 + lane; const float* w = p.k->w_mod + (size_t)l * 1024 * 3072 + col;
          float a[17];
#pragma unroll
          for (int r = 0; r < 17; ++r) a[r] = 0.f;
          for (int k0 = wv * 128; k0 < wv * 128 + 128; k0 += 16) {
              float wq[16];
#pragma unroll
              for (int q = 0; q < 16; ++q) wq[q] = w[(size_t)(k0 + q) * 3072];
#pragma unroll
              for (int q = 0; q < 16; ++q) {
#pragma unroll
                  for (int r = 0; r < 17; ++r) a[r] += sc[r * 1024 + k0 + q] * wq[q]; } }
#pragma unroll
          for (int r = 0; r < 17; ++r) red[(wv * 17 + r) * 64 + lane] = a[r];
          __syncthreads();
          for (int i = tid; i < 17 * 64; i += 512) { const int r = i >> 6, ln = i & 63; float s = 0.f;
#pragma unroll
              for (int w8 = 0; w8 < 8; ++w8) s += red[(w8 * 17 + r) * 64 + ln];
              const int cc = (job % 48) * 64 + ln; ((float*)(p.k->ws + OFF_MOD))[((size_t)l * 17 + r) * 3072 + cc] = s + p.k->b_mod[l * 3072 + cc]; }
          __syncthreads();
      } }
}

DI void phase_prep(LAS unsigned char* lds, const Params& p, int layer) {
    const int tid = ltid(p.wvid), lane = tid & 63, wv = tid >> 6;
    bf16_t* Z = (bf16_t*)(p.k->ws + OFF_ZQK);
    { const bool isK = lane >= 16; const int l2 = lane & 31;
      const float* gptr = p.k->na_qk_gain + (layer * 2 + ((l2 >= 16) ? 1 : 0)) * 64 + (l2 & 3) * 16;
      float gn[16];
#pragma unroll
      for (int j = 0; j < 16; ++j) gn[j] = gptr[j];
      (void)isK;
      const int stride = gridDim.x * 16;
      for (int rowa = lbid() * 16 + wv * 2 + (lane >> 5); rowa < TT; rowa += 2 * stride) {
          u32x4 ua[2][2];
#pragma unroll
          for (int r2 = 0; r2 < 2; ++r2) { const int row = rowa + r2 * stride; if (row < TT) { const u32x4* zq = (const u32x4*)(Z + (size_t)row * 1024 + 512 + l2 * 16); ua[r2][0] = zq[0]; ua[r2][1] = zq[1]; } }
#pragma unroll
          for (int r2 = 0; r2 < 2; ++r2) { const int row = rowa + r2 * stride; if (row < TT) {
              u32x4* zp = (u32x4*)(Z + (size_t)row * 1024 + 512 + l2 * 16); const u32x4 u0 = ua[r2][0], u1 = ua[r2][1];
              float v[16]; v[0] = bflo(u0.x); v[1] = bfhi(u0.x); v[2] = bflo(u0.y); v[3] = bfhi(u0.y); v[4] = bflo(u0.z); v[5] = bfhi(u0.z); v[6] = bflo(u0.w); v[7] = bfhi(u0.w);
              v[8] = bflo(u1.x); v[9] = bfhi(u1.x); v[10] = bflo(u1.y); v[11] = bfhi(u1.y); v[12] = bflo(u1.z); v[13] = bfhi(u1.z); v[14] = bflo(u1.w); v[15] = bfhi(u1.w);
              float ss = 0.f;
#pragma unroll
              for (int j = 0; j < 16; ++j) ss += v[j] * v[j];
              ss += __shfl_xor(ss, 1); ss += __shfl_xor(ss, 2);
              const float r = rsqrtf(ss * (1.f / 64.f) + EPS);
#pragma unroll
              for (int j = 0; j < 16; ++j) v[j] = v[j] * r * gn[j];
              u32x4 o0, o1; o0.x = pack2(v[0], v[1]); o0.y = pack2(v[2], v[3]); o0.z = pack2(v[4], v[5]); o0.w = pack2(v[6], v[7]);
              o1.x = pack2(v[8], v[9]); o1.y = pack2(v[10], v[11]); o1.z = pack2(v[12], v[13]); o1.w = pack2(v[14], v[15]); zp[0] = o0; zp[1] = o1;
          } }
      } }
    { const bf16_t* CQ = (const bf16_t*)(p.k->ws + OFF_CQ); LAS float* part = (LAS float*)lds;
      const int ch = tid & 255, hf = tid >> 8;
      for (int item = lbid(); item < NB * NSLOT * 2; item += gridDim.x) {
          const int dir = item & 1, slot = (item >> 1) % NSLOT, b = (item >> 1) / NSLOT;
          const int row0 = slot < 32 ? b * SEQ + 64 * slot : TL + b * CTX + 64 * (slot - 32);
          float* G = (float*)(p.k->ws + OFF_G) + (size_t)dir * TT * 256 + (size_t)row0 * 256 + ch;
          const float* misc = (const float*)(p.k->ws + OFF_MISC);
          const float lbv = __expf(misc[MISC_LOGLB + (dir * 4 + layer) * 256 + ch]), omlb = __expf(misc[MISC_LOG1M + (dir * 4 + layer) * 256 + ch]);
          auto logf_gate = [&](float f) { const float sg = __builtin_amdgcn_rcpf(1.f + __builtin_amdgcn_exp2f(-1.4426950408889634f * f)); return __logf(__builtin_fmaf(omlb, sg, lbv)); };
          float ps = 0.f, gv[32];
#pragma unroll
          for (int t8 = 0; t8 < 32; t8 += 8) {
              float fv[8];
#pragma unroll
              for (int q = 0; q < 8; ++q) fv[q] = G[(size_t)(32 * hf + t8 + q) * 256];
#pragma unroll
              for (int q = 0; q < 8; ++q) { gv[t8 + q] = logf_gate(fv[q]); ps += gv[t8 + q]; }
          }
          __syncthreads(); part[hf * 256 + ch] = ps; __syncthreads();
          const float p0 = part[ch], p1 = part[256 + ch]; const float blast = p0 + p1; const float mref = dir == 0 ? p0 : p1;
          float bc = dir == 0 ? (hf ? p0 : 0.f) : (hf ? 0.f : p1); const float elm = __expf(blast - mref);
          unsigned* QK = (unsigned*)G;
          bf16_t* KDT = (bf16_t*)(p.k->ws + OFF_KDT) + (((size_t)dir * NB + b) * 256 + ch) * KEYS + 64 * slot + 32 * hf;
          const bf16_t* cq = CQ + (size_t)row0 * 256 + ch;
#pragma unroll
          for (int o8 = 0; o8 < 4; ++o8) {
              float kv[8], cqv[8];
#pragma unroll
              for (int q = 0; q < 8; ++q) { const int tl = dir == 0 ? (o8 * 8 + q) : (31 - (o8 * 8 + q)); cqv[q] = bf2f(cq[(size_t)(32 * hf + tl) * 256]); }
#pragma unroll
              for (int q = 0; q < 8; ++q) {
                  const int tl = dir == 0 ? (o8 * 8 + q) : (31 - (o8 * 8 + q)); const int tau = 32 * hf + tl;
                  const float g = dir == 0 ? gv[o8 * 8 + q] : gv[31 - (o8 * 8 + q)]; bc += g;
                  const float qv = cqv[q]; const float k = 1.f - __expf(g);
                  const float e = __expf(bc - mref); const float kdv = k * __builtin_amdgcn_rcpf(e);
                  QK[(size_t)tau * 256] = pack2(qv * e, kdv);
                  kv[dir == 0 ? q : 7 - q] = kdv * elm;
              }
              const int t8 = dir == 0 ? o8 * 8 : 24 - o8 * 8;
              *(u32x4*)(KDT + t8) = __builtin_bit_cast(u32x4, pack8(kv[0], kv[1], kv[2], kv[3], kv[4], kv[5], kv[6], kv[7]));
          }
          if (hf == 0) { float* ev = (float*)(p.k->ws + OFF_EV) + (((size_t)dir * NB + b) * NSLOT + slot) * 3 * 256 + ch; ev[0] = __expf(blast); ev[256] = __expf(mref); ev[512] = __expf(blast - mref); }
      } }
}

DI void phase_post(const Params& p, int layer) {
    const int lane = ltid(p.wvid) & 63, wv = ltid(p.wvid) >> 6;
    const unsigned* O0 = (const unsigned*)(p.k->ws + OFF_G); const unsigned* O1 = O0 + (size_t)TT * 256; bf16_t* Y = (bf16_t*)(p.k->ws + OFF_YG);
    const f32x4 gn = *(const f32x4*)(p.k->hg_norm_gain + layer * 64 + (lane & 15) * 4);
    const int stride = gridDim.x * 8;
    for (int rowa = lbid() * 8 + wv; rowa < TT; rowa += 4 * stride) {
        u32x4 a[4], bq[4]; u32x2 sgv[4];
#pragma unroll
        for (int r4 = 0; r4 < 4; ++r4) { const int row = rowa + r4 * stride; if (row < TT) { a[r4] = *(const u32x4*)(O0 + (size_t)row * 256 + lane * 4); bq[r4] = *(const u32x4*)(O1 + (size_t)row * 256 + lane * 4);
            sgv[r4] = *(const u32x2*)(Y + (size_t)row * 1024 + 512 + lane * 4); } }
#pragma unroll
        for (int r4 = 0; r4 < 4; ++r4) { const int row = rowa + r4 * stride; if (row < TT) {
            f32x4 v; v[0] = bflo(a[r4].x) + bflo(bq[r4].x); v[1] = bflo(a[r4].y) + bflo(bq[r4].y); v[2] = bflo(a[r4].z) + bflo(bq[r4].z); v[3] = bflo(a[r4].w) + bflo(bq[r4].w);
            float ss = v[0] * v[0] + v[1] * v[1] + v[2] * v[2] + v[3] * v[3];
            ss += __shfl_xor(ss, 1); ss += __shfl_xor(ss, 2); ss += __shfl_xor(ss, 4); ss += __shfl_xor(ss, 8);
            const float r = rsqrtf(ss * (1.f / 64.f) + EPS);
            const u32x2 sg = sgv[r4]; u32x2 o;
            o.x = pack2(v[0] * r * gn[0] * bflo(sg.x), v[1] * r * gn[1] * bfhi(sg.x)); o.y = pack2(v[2] * r * gn[2] * bflo(sg.y), v[3] * r * gn[3] * bfhi(sg.y));
            *(u32x2*)(Y + (size_t)row * 1024 + 512 + lane * 4) = o; } }
    }
}

DI void phase_mix(LAS unsigned char* lds, const Params& p, int layer) {
    const int tid = ltid(p.wvid), wv = tid >> 6, lane = tid & 63; const bool need_ctx = layer < DEPTH - 1;
#if defined(SELC)
    const int sel = SELC;
#elif defined(MIXSEL)
    const int sel = p.pad_ ? MIXSEL : 15;
#else
    const int sel = 15;
#endif
    if ((sel & 1) && lbid() < 64) hgrn_item(lds, p, lbid() * 2 + (wv >> 2), wv >> 2, wv & 3, lane);
    if ((sel & 2) && lbid() >= 128) {
        const int u = lbid() - 128; SchedOne S; S.u.pm = u >> 4; S.u.pn = u & 15; S.u.sub = 0; S.u.nt = 64;
        S.u.A = (const char*)(p.k->ws + OFF_DFTL) + (size_t)S.u.pm * 256 * 4096 * 2; S.u.B = (const char*)(p.k->ws + OFF_FBL) + (size_t)S.u.pn * 256 * 4096 * 2;
        EpiFour E; E.Y = (bf16_t*)(p.k->ws + OFF_YG); E.rowbase = S.u.pn * SEQ;
        gemm_phase<true>(lds, p.wvid, 4096, 4096, S, E);
        if (need_ctx && u < 16) { SchedOne S2; S2.u.pm = 0; S2.u.pn = u; S2.u.sub = 0; S2.u.nt = 8;
            S2.u.A = (const char*)(p.k->ws + OFF_DFTC); S2.u.B = (const char*)(p.k->ws + OFF_FBC) + (size_t)u * 256 * 512 * 2;
            EpiFour E2; E2.Y = E.Y; E2.rowbase = TL + u * CTX; gemm_phase<true>(lds, p.wvid, 512, 512, S2, E2); }
    }
    int* ctr = (int*)(p.k->ws + OFF_MISC) + MISC_CTR + layer + p.pad_; LAS int* slot = (LAS int*)(lds + LDS_MISC);
    const int nitems = need_ctx ? 1152 : 1024;
    __syncthreads();
    if (tid == 0) *slot = atomicAdd(ctr, 1);
    __syncthreads();
    for (;;) {
        const int it = *slot;
        __syncthreads();
        if (it >= nitems) break;
        if (tid == 0) *slot = atomicAdd(ctr, 1);
        if (it < 512 && (sel & 4)) { const int b = it >> 5, h = (it >> 3) & 3, qb = it & 7; attn_unit<0>(lds, p, layer, b, h, 0, b * SEQ + qb * 256, 0); }
        if (it >= 512 && it < 1024 && (sel & 8)) { const int j = it - 512; const int b = j >> 5, h = (j >> 3) & 3, R = j & 7; attn_unit<1>(lds, p, layer, b, h, 2, b * SEQ + R * 256, R); }
        if (it >= 1024 && it < 1088 && (sel & 4)) { const int j = it - 1024; const int b = j >> 2, h = j & 3; attn_unit<0>(lds, p, layer, b, h, 1, TL + b * CTX, 0); }
        if (it >= 1088 && (sel & 8)) { const int j = it - 1088; const int b = j >> 2, h = j & 3; attn_unit<1>(lds, p, layer, b, h, 1, TL + b * CTX, 0); }
        __syncthreads();
    }
}

DI void run_phase(LAS unsigned char* lds, const Params& pin, int ph) {
    Params p = pin; asm volatile("" : "+s"(p.k));
#ifdef ONLY
    if (ph == 0) return;
#else
    if (ph == 0) { phase_pro(lds, p); return; }
#endif
#ifdef PROBE_SUB
    const int layer = ph >= 100 ? 0 : (ph - 1) / 7, sub = ph >= 100 ? ph - 100 : (ph - 1) % 7; const bool last = layer == DEPTH - 1;
#else
    const int layer = (ph - 1) / 7, sub = (ph - 1) % 7; const bool last = layer == DEPTH - 1;
#endif
#ifdef ONLY
    if (sub != ONLY) return;
#endif
    switch (sub) {
    case 0: if (layer == 0) phase_weights(lds, p, 0, lbid(), gridDim.x); phase_h(p, layer); break;
    case 1: { SchedG1 S; S.nM = TT / 256; S.nN = 16; S.G = gridDim.x; S.c = lbid(); S.A = (const char*)(p.k->ws + OFF_H); S.B = (const char*)(p.k->ws + wsel(layer) + OFF_WIN);
        EpiG1 E; E.ws = p.k->ws; E.layer = layer; E.qkg = p.k->da_qk_gain + layer * 64; E.rope = (const float*)(p.k->ws + OFF_ROPE); gemm_phase<true>(lds, p.wvid, 1024, 1024, S, E); } break;
    case 2: phase_prep(lds, p, layer); break;
    case 3: phase_mix(lds, p, layer); break;
    case 4: phase_post(p, layer); break;
    case 5: { SchedG2 S; S.nM = last ? TL / 256 : TT / 256; S.G = gridDim.x; S.c = lbid(); S.YG = (const char*)(p.k->ws + OFF_YG); S.WUP = (const char*)(p.k->ws + wsel(layer) + OFF_WUP);
        S.H = (const char*)(p.k->ws + OFF_H); S.WM = (const char*)(p.k->ws + wsel(layer) + OFF_WM);
        EpiG2 E; E.brs = (u32x4*)(p.k->ws + OFF_BRS) + (size_t)lbid() * 512 * 16; E.accs = (u32x4*)(p.k->ws + OFF_ACCS) + (size_t)lbid() * 512 * 16; E.ACC = (bf16_t*)(p.k->ws + OFF_ACC);
        const int su = lbid() & 63, pr = lbid() >> 6; E.t4 = (u32x4*)(p.k->ws + OFF_T4) + ((size_t)(su * 4 + pr) * 16) * 512;
        gemm_phase<true>(lds, p.wvid, 1024, 1024, S, E);
        if (!last) {
            const int tid = ltid(p.wvid); LAS unsigned* sl = (LAS unsigned*)(lds + LDS_MISC + 32);
            __syncthreads();
            if (tid == 0) { __builtin_amdgcn_fence(__ATOMIC_RELEASE, "agent"); asm volatile("s_waitcnt vmcnt(0)" ::: "memory");
                *sl = xb_add((unsigned*)(p.k->ws + OFF_BAR) + XB_SPLITCNT + layer * 64 + su, 1u); }
            __syncthreads();
            if (*sl == 3u) {
                __builtin_amdgcn_fence(__ATOMIC_ACQUIRE, "agent"); asm volatile("s_waitcnt vmcnt(0)" ::: "memory");
                int pm, pn; tile_order(2 * (int)gridDim.x + su, S.nM, 4, pm, pn);
                const int w2 = tid >> 6, fr = tid & 15, fq = (tid >> 4) & 3; const int row0 = pm * 256 + (w2 >> 2) * 64 + fr, col0 = pn * 256 + (w2 & 3) * 32 + 8 * fq;
                const u32x4* T = (const u32x4*)(p.k->ws + OFF_T4) + ((size_t)(su * 4) * 16) * 512 + tid; bf16_t* ACC = (bf16_t*)(p.k->ws + OFF_ACC);
                for (int idx = 0; idx < 16; ++idx) {
                    u32x4 tq[4];
#pragma unroll
                    for (int q = 0; q < 4; ++q) tq[q] = T[((size_t)q * 16 + idx) * 512];
                    float t[8] = {0.f, 0.f, 0.f, 0.f, 0.f, 0.f, 0.f, 0.f};
#pragma unroll
                    for (int q = 0; q < 4; ++q) { t[0] += bflo(tq[q].x); t[1] += bfhi(tq[q].x); t[2] += bflo(tq[q].y); t[3] += bfhi(tq[q].y); t[4] += bflo(tq[q].z); t[5] += bfhi(tq[q].z); t[6] += bflo(tq[q].w); t[7] += bfhi(tq[q].w); }
                    u32x4 o; o.x = pack2(t[0], t[1]); o.y = pack2(t[2], t[3]); o.z = pack2(t[4], t[5]); o.w = pack2(t[6], t[7]);
                    const int ai = idx >> 3, m = (idx >> 1) & 3, bj = idx & 1;
                    *(u32x4*)(ACC + (size_t)(row0 + ai * 128 + m * 16) * 1024 + col0 + bj * 128) = o;
                }
            }
        } }
        break;
    case 7: break;
    case 6: { SchedG3 S; S.nM = last ? TL / 256 : TT / 256; S.G = gridDim.x; S.c = lbid(); S.A = (const char*)(p.k->ws + OFF_ACC); S.B = (const char*)(p.k->ws + wsel(layer) + OFF_WO);
        EpiG3 E; E.p = p; E.layer = layer; gemm_phase<true>(lds, p.wvid, 1024, 1024, S, E);
        if (!last && lbid() >= 64) phase_weights(lds, p, layer + 1, lbid() - 64, 192); }
        break;
    }
}

constexpr int NPHASE = 1 + 7 * DEPTH;

__global__ void __launch_bounds__(512, 2) mega(KArgs ka) {
    Params p; p.k = (KPtr)__builtin_amdgcn_kernarg_segment_ptr(); p.pad_ = 0; p.wvid = __builtin_amdgcn_readfirstlane((int)threadIdx.x >> 6);
    extern __shared__ __attribute__((aligned(16))) unsigned char shm[];
    LAS unsigned char* lds = (LAS unsigned char*)shm;
#if COOP
    cg::grid_group grid = cg::this_grid();
    volatile LAS unsigned* xst = (volatile LAS unsigned*)(lds + LDS_MISC + 16);
    { const int t0 = ltid(p.wvid); if (t0 == 0) { xst[0] = 0u; xst[1] = 0u; } __syncthreads(); }
    const XcdBarrier xb = xcd_barrier_post((unsigned*)(p.k->ws + OFF_BAR), xst, ltid(p.wvid));
#ifdef PROBE_SUB
    constexpr int NPRE = 1 + PROBE_REP;
    for (int s = 0; s < NPRE + NPHASE; ++s) {
        const int ph = s < NPRE ? (s == 0 ? 0 : 100 + PROBE_SUB) : s - NPRE;
        p.pad_ = (s >= 1 && s < NPRE) ? 4 + ((s - 1) & 3) : 0;
        run_phase(lds, p, ph); if (s + 1 < NPRE + NPHASE) { if (s == 0) grid.sync(); else xcd_barrier(xb, ltid(p.wvid)); }
    }
#else
    for (int ph = p.k->phase_lo; ph < p.k->phase_hi; ++ph) { run_phase(lds, p, ph); if (ph + 1 < p.k->phase_hi) { if (ph == 0) grid.sync(); else xcd_barrier(xb, ltid(p.wvid)); } }
#endif
#else
    for (int ph = p.k->phase_lo; ph < p.k->phase_hi; ++ph) run_phase(lds, p, ph);
#endif
}

extern "C" void kernel_launch(void* const* d_in, const int* in_sizes, int n_in, void* d_out, int out_size, void* d_ws, size_t ws_size, hipStream_t stream) {
    if (ws_size < OFF_END) { fprintf(stderr, "workspace too small: %zu < %zu\n", ws_size, (size_t)OFF_END); return; }
    KArgs p{};
    const float** f = (const float**)&p;
    for (int i = 0; i < 18; ++i) f[i] = (const float*)d_in[i];
    p.out = (float*)d_out; p.ws = (unsigned char*)d_ws;
    static bool attr = false;
    if (!attr) { (void)hipFuncSetAttribute((const void*)mega, hipFuncAttributeMaxDynamicSharedMemorySize, LDS_BYTES); attr = true; }
#if COOP
    p.phase_lo = 0; p.phase_hi = NPHASE;
    (void)hipMemsetAsync((unsigned char*)d_ws + OFF_BAR, 0, 16384, stream);
    void* args[] = {&p};
    hipError_t e = hipLaunchCooperativeKernel((const void*)mega, dim3(256), dim3(512), args, LDS_BYTES, stream);
    if (e != hipSuccess) fprintf(stderr, "cooperative launch failed: %s\n", hipGetErrorString(e));
#else
    for (int ph = 0; ph < NPHASE; ++ph) { p.phase_lo = ph; p.phase_hi = ph + 1; hipLaunchKernelGGL(mega, dim3(256), dim3(512), LDS_BYTES, stream, p); }
#endif
}
```

```cpp
#include <hip/hip_runtime.h>
#include <hip/hip_cooperative_groups.h>
#include <cstdio>
namespace cg = cooperative_groups;

#ifndef COOP
#define COOP 1
#endif

#define LAS __attribute__((address_space(3)))
#define DI __device__ __forceinline__
typedef unsigned short bf16_t;
typedef short bf16x8 __attribute__((ext_vector_type(8)));
typedef float f32x4 __attribute__((ext_vector_type(4)));
typedef float f32x16 __attribute__((ext_vector_type(16)));
typedef unsigned u32x4 __attribute__((ext_vector_type(4)));
typedef unsigned u32x2 __attribute__((ext_vector_type(2)));

constexpr int DM = 1024, NB = 16, SEQ = 2048, DEPTH = 4, CTX = 256;
constexpr int TL = NB * SEQ, TC = NB * CTX, TT = TL + TC;
constexpr int KEYS = SEQ + CTX;
constexpr int NSLOT = KEYS / 64;
constexpr float EPS = 1e-6f;
constexpr float LOG2E = 1.4426950408889634f;

constexpr size_t SZ_XC = (size_t)TC * DM * 4;
constexpr size_t SZ_MOD = 1u << 20;
constexpr size_t SZ_MISC = 1u << 16;
constexpr size_t SZ_WIN = (size_t)4096 * 1024 * 2, SZ_WUP = (size_t)1024 * 1024 * 2, SZ_WM = (size_t)4096 * 1024 * 2, SZ_WO = (size_t)1024 * 1024 * 2;
constexpr size_t SZ_DFTL = (size_t)2048 * 4096 * 2, SZ_DFTC = (size_t)256 * 512 * 2;
constexpr size_t SZ_TOK256 = (size_t)TT * 256 * 2;
constexpr size_t SZ_TOK1024 = (size_t)TT * 1024 * 2;
constexpr size_t SZ_VT = (size_t)NB * 256 * KEYS * 2;
constexpr size_t SZ_EV = (size_t)2 * NB * NSLOT * 3 * 256 * 4;
constexpr size_t SZ_FBL = (size_t)4096 * 4096 * 2, SZ_FBC = (size_t)4096 * 512 * 2;
constexpr size_t SZ_G = (size_t)2 * TT * 256 * 4;
constexpr size_t SZ_SCR = (size_t)256 * 512 * 128 * 4;

constexpr size_t OFF_XC = 0;
constexpr size_t OFF_MOD = OFF_XC + SZ_XC;
constexpr size_t OFF_MISC = OFF_MOD + SZ_MOD;
constexpr size_t OFF_WIN = OFF_MISC + SZ_MISC;
constexpr size_t OFF_WUP = OFF_WIN + SZ_WIN;
constexpr size_t OFF_WM = OFF_WUP + SZ_WUP;
constexpr size_t OFF_WO = OFF_WM + SZ_WM;
constexpr size_t OFF_DFTL = OFF_WO + SZ_WO;
constexpr size_t OFF_DFTC = OFF_DFTL + SZ_DFTL;
constexpr size_t OFF_HG = OFF_DFTC + SZ_DFTC;
constexpr size_t OFF_QD = OFF_HG, OFF_KD = OFF_QD + 2 * SZ_TOK256, OFF_KDT = OFF_KD + 2 * SZ_TOK256;
constexpr size_t OFF_H = OFF_HG;
constexpr size_t OFF_EV = OFF_KDT + 2 * SZ_VT;
constexpr size_t OFF_ZQK = OFF_EV + SZ_EV;
constexpr size_t OFF_ACC = OFF_ZQK;
constexpr size_t OFF_YG = OFF_ZQK + SZ_TOK1024;
constexpr size_t OFF_VT = OFF_YG + SZ_TOK1024;
constexpr size_t OFF_FBL = OFF_VT + 3 * SZ_VT;
constexpr size_t OFF_FBC = OFF_FBL + SZ_FBL;
constexpr size_t OFF_G = OFF_FBC + SZ_FBC;
constexpr size_t OFF_O32 = OFF_G;
constexpr size_t OFF_CQ = OFF_G + SZ_G;
constexpr size_t OFF_ROPE = OFF_CQ + SZ_TOK256;
constexpr size_t OFF_BAR = OFF_ROPE + (size_t)2048 * 32 * 4;
constexpr size_t OFF_W2 = OFF_BAR + 16384;
constexpr size_t SZ_W = SZ_WIN + SZ_WUP + SZ_WM + SZ_WO;
constexpr size_t OFF_END = OFF_W2 + SZ_W;
static_assert(OFF_WUP == OFF_WIN + SZ_WIN && OFF_WM == OFF_WUP + SZ_WUP && OFF_WO == OFF_WM + SZ_WM, "weight set must be contiguous");
static_assert(OFF_END <= (size_t)536870912, "workspace budget");
constexpr size_t OFF_BRS = OFF_VT, OFF_ACCS = OFF_BRS + SZ_SCR;
constexpr size_t OFF_T4 = OFF_BRS + 33554432;
static_assert(OFF_T4 + 33554432 <= OFF_ACCS, "T4 overlaps the partial-sum stash");
constexpr int XB_SPLITCNT = 3584;
static_assert(OFF_ACCS + SZ_SCR <= OFF_ROPE, "scratch alias overflow");
static_assert(SZ_TOK1024 == 4 * SZ_TOK256, "H alias");

constexpr int MISC_LOGLB = 0;
constexpr int MISC_LOG1M = 2048;
constexpr int MISC_LAM = 4096;
constexpr int MISC_CTR = 4160;

constexpr int LDS_BYTES = 131072 + 4096;
constexpr int LDS_MISC = 131072;

struct KArgs {
    const float *x, *c, *ctx, *c_ctx, *norm_gain, *w_mod, *b_mod, *w_in, *da_qk_gain, *da_lambda, *da_subln_gain, *na_qk_gain, *na_rpb, *hg_lb_logits, *hg_norm_gain, *w_up, *w_merge, *w_out;
    float* out;
    unsigned char* ws;
    int phase_lo, phase_hi;
};
typedef const KArgs __attribute__((address_space(4)))* KPtr;
struct Params { KPtr k; int wvid, pad_; };

DI int ltid(int wvid) { int t; asm volatile("v_mbcnt_lo_u32_b32 %0, -1, 0\n\tv_mbcnt_hi_u32_b32 %0, -1, %0" : "=v"(t)); return wvid * 64 + t; }
DI int lbid() { int b = (int)blockIdx.x; asm volatile("" : "+s"(b)); return b; }
typedef float f32x2v __attribute__((ext_vector_type(2)));
typedef __bf16 bf16x2v __attribute__((ext_vector_type(2)));
DI unsigned short f2bf(float f) { __bf16 b = (__bf16)f; return __builtin_bit_cast(unsigned short, b); }
DI float bf2f(unsigned short b) { return __uint_as_float(((unsigned)b) << 16); }
DI unsigned pack2(float lo, float hi) { f32x2v v = {lo, hi}; bf16x2v r = __builtin_convertvector(v, bf16x2v); return __builtin_bit_cast(unsigned, r); }
DI float bflo(unsigned u) { return __uint_as_float(u << 16); }
DI float bfhi(unsigned u) { return __uint_as_float(u & 0xffff0000u); }
DI u32x2 mku2(unsigned a, unsigned b) { u32x2 r; r.x = a; r.y = b; return r; }
DI bf16x8 mk8(u32x2 a, u32x2 b) { u32x4 u; u.x = a.x; u.y = a.y; u.z = b.x; u.w = b.y; return __builtin_bit_cast(bf16x8, u); }
DI bf16x8 mk8u(u32x4 u) { return __builtin_bit_cast(bf16x8, u); }
DI bf16x8 pack8(float a, float b, float c, float d, float e, float f, float g, float h) { u32x4 u; u.x = pack2(a, b); u.y = pack2(c, d); u.z = pack2(e, f); u.w = pack2(g, h); return __builtin_bit_cast(bf16x8, u); }
DI float siluf(float v) { return v * __builtin_amdgcn_rcpf(1.f + __builtin_amdgcn_exp2f(-1.4426950408889634f * v)); }
DI float sigmoidf_(float v) { return __builtin_amdgcn_rcpf(1.f + __builtin_amdgcn_exp2f(-1.4426950408889634f * v)); }
DI int crow(int i, int h) { return (i & 3) + 8 * (i >> 2) + 4 * h; }
#define MFMA32(a, b, c) __builtin_amdgcn_mfma_f32_32x32x16_bf16((a), (b), (c), 0, 0, 0)
DI f32x16 zero16() { f32x16 z; for (int i = 0; i < 16; ++i) z[i] = 0.f; return z; }
DI const float* xrow_in(const Params& p, int layer, int row) {
    if (layer == 0) return row < TL ? p.k->x + (size_t)row * DM : p.k->ctx + (size_t)(row - TL) * DM;
    return row < TL ? p.k->out + (size_t)row * DM : (const float*)(p.k->ws + OFF_XC) + (size_t)(row - TL) * DM; }
DI size_t wsel(int layer) { return (layer & 1) ? (OFF_W2 - OFF_WIN) : 0; }
DI float* xrow(const Params& p, int row) { return row < TL ? p.k->out + (size_t)row * DM : (float*)(p.k->ws + OFF_XC) + (size_t)(row - TL) * DM; }

#define XB_TMO      128
#define XB_XCNT(j)  (256  + 64 * (j))
#define XB_XSUB(j)  (1280 + 64 * (j))
#define XB_XGEN(j)  (2304 + 64 * (j))
#define XB_TOP      3328
#define XB_TOPGEN   3392
#define XCD_BAR_WORDS 3456
#define XB_SPIN_CAP (1u << 18)
DI unsigned xb_ld(unsigned* p) { return __hip_atomic_load(p, __ATOMIC_RELAXED, __HIP_MEMORY_SCOPE_AGENT); }
DI unsigned xb_add(unsigned* p, unsigned v) { return __hip_atomic_fetch_add(p, v, __ATOMIC_RELAXED, __HIP_MEMORY_SCOPE_AGENT); }
DI unsigned xb_xcc_id() { return (unsigned)__builtin_amdgcn_s_getreg((3 << 11) | 20) & 0xFu; }
#define XB_SPIN(cond, bar) do { unsigned _sp = 0; while (cond) { __builtin_amdgcn_s_sleep(1); \
    if ((++_sp & 255u) == 0u) { if (xb_ld(&(bar)[XB_TMO])) break; if (_sp > XB_SPIN_CAP) { atomicAdd(&(bar)[XB_TMO], 1u); break; } } } } while (0)
struct XcdBarrier { unsigned* bar; unsigned x; volatile LAS unsigned* st; };
DI XcdBarrier xcd_barrier_post(unsigned* bar, volatile LAS unsigned* st, int tid) {
    XcdBarrier b; b.bar = bar; b.x = xb_xcc_id(); b.st = st;
    if (tid == 0) (void)xb_add(&bar[XB_XCNT(b.x)], 1u);
    return b;
}
DI void xcd_barrier_complete(unsigned* bar, unsigned x, unsigned& nloc, unsigned& nx) {
    const unsigned G = gridDim.x;
    unsigned sum, cnt, mine, sp = 0u;
    for (;;) {
        sum = 0u; cnt = 0u; mine = 0u;
#pragma unroll
        for (unsigned j = 0; j < 16; ++j) { const unsigned c = xb_ld(&bar[XB_XCNT(j)]); sum += c; cnt += (c > 0u) ? 1u : 0u; mine = (j == x) ? c : mine; }
        if (sum == G) break;
        __builtin_amdgcn_s_sleep(1);
        if ((++sp & 255u) == 0u) { if (xb_ld(&bar[XB_TMO])) break; if (sp > XB_SPIN_CAP) { atomicAdd(&bar[XB_TMO], 1u); break; } }
    }
    nloc = mine > 0u ? mine : 1u; nx = cnt > 0u ? cnt : 1u;
}
DI void xcd_barrier(const XcdBarrier& b, int tid) {
    asm volatile("s_waitcnt vmcnt(0)" ::: "memory");
    __syncthreads();
    if (tid == 0) {
        unsigned* bar = b.bar;
        __builtin_amdgcn_s_waitcnt(0);
        unsigned nloc = b.st[0], nx = b.st[1];
        if (nloc == 0u) { xcd_barrier_complete(bar, b.x, nloc, nx); b.st[0] = nloc; b.st[1] = nx; }
        const unsigned old = xb_add(&bar[XB_XSUB(b.x)], 1u);
        const unsigned gen = old / nloc;
        if (old + 1u == (gen + 1u) * nloc) {
            __builtin_amdgcn_fence(__ATOMIC_RELEASE, "agent");
            asm volatile("s_waitcnt vmcnt(0)" ::: "memory");
            const unsigned og = xb_add(&bar[XB_TOP], 1u);
            const unsigned tg = og / nx;
            if (og + 1u == (tg + 1u) * nx) xb_add(&bar[XB_TOPGEN], 1u);
            else XB_SPIN(xb_ld(&bar[XB_TOPGEN]) == tg, bar);
            __builtin_amdgcn_fence(__ATOMIC_ACQUIRE, "agent");
            xb_add(&bar[XB_XGEN(b.x)], 1u);
            asm volatile("s_waitcnt vmcnt(0)" ::: "memory");
        } else {
            XB_SPIN(xb_ld(&bar[XB_XGEN(b.x)]) == gen, bar);
            __builtin_amdgcn_fence(__ATOMIC_ACQUIRE, "agent");
            asm volatile("s_waitcnt vmcnt(0)" ::: "memory");
        }
    }
    __syncthreads();
}

constexpr int BM = 256, BK = 64, HALF = 128, HTB = HALF * BK * 2, NXCD = 8, WGM = 8;
DI int lds_byte(int r, int c) { const int st = (r >> 4) * 2 + (c >> 5), rr = r & 15, cc = c & 31, ob = rr * 64 + cc * 2; return st * 1024 + (ob ^ (((ob >> 9) & 1) << 5)); }
DI void stage_rc(int b, int& R, int& C) { const int st = b / 1024, sb = b % 1024, swz = sb ^ (((sb >> 9) & 1) << 5); R = (st >> 1) * 16 + swz / 64; C = (st & 1) * 32 + (swz % 64) / 2; }
DI int perm32(int rho) { const int n = rho >> 4, i = rho & 15; return 8 * (i >> 2) + 4 * n + (i & 3); }

struct GUnit { const char* A; const char* B; int nt, pm, pn, sub; };

DI void tile_order(int L, int nM, int nN, int& pm, int& pn) {
    const int nwg = nM * nN; int wgid = L;
    { const int q = nwg / NXCD, r = nwg % NXCD, xcd = wgid % NXCD, off = wgid / NXCD; wgid = (xcd < r ? xcd * (q + 1) : r * (q + 1) + (xcd - r) * q) + off; }
    const int nig = WGM * nN, gid = wgid / nig, fm = gid * WGM, gsz = (nM - fm) < WGM ? (nM - fm) : WGM;
    pm = fm + ((wgid % nig) % gsz); pn = (wgid % nig) / gsz;
}

template <bool PERM, class Sched, class Epi>
DI void gemm_phase(LAS unsigned char* lds, const int wvid, const int lda, const int ldb, const Sched& S, const Epi& E) {
    const int tid = ltid(wvid), wid = __builtin_amdgcn_readfirstlane(tid >> 6), lane = tid & 63, wr = wid >> 2, wc = wid & 3, fr = lane & 15, fq = lane >> 4;
    unsigned voffA[2], voffB[2];
#pragma unroll
    for (int i = 0; i < 2; ++i) { int R, C; stage_rc(tid * 16 + i * 8192, R, C); const int Rb = PERM ? ((R & ~31) + perm32(R & 31)) : R;
        voffA[i] = (unsigned)(R * lda + C) * 2u; voffB[i] = (unsigned)(Rb * ldb + C) * 2u; }
    const size_t kstep = (size_t)(BK * 2);
    const size_t hstepA = (size_t)HALF * lda * 2, hstepB = (size_t)HALF * ldb * 2;
    const unsigned ldsw = (unsigned)wid * 1024u;
    const int aoff = lds_byte(wr * 64 + fr, fq * 8), boff = lds_byte(wc * 32 + fr, fq * 8);
#define PG8_SA(b, h) (((b) * 2 + (h)) * HTB)
#define PG8_SB(b, h) ((4 + (b) * 2 + (h)) * HTB)
#define PG8_STAGE(bufoff, gbase, voff) do { _Pragma("unroll") for (int _i = 0; _i < 2; ++_i) \
        __builtin_amdgcn_global_load_lds((const unsigned*)((const char*)(gbase) + (voff)[_i]), (LAS unsigned*)(lds + (bufoff) + ldsw + _i * 8192), 16, 0, 0); } while (0)
#define PG8_LDA(dst, b, h) do { _Pragma("unroll") for (int m = 0; m < 4; ++m) _Pragma("unroll") for (int k = 0; k < 2; ++k) dst[m][k] = *(const LAS bf16x8*)(lds + PG8_SA(b, h) + aoff + m * 2048 + k * 1024); } while (0)
#define PG8_LDB(dst, b, h) do { _Pragma("unroll") for (int n = 0; n < 2; ++n) _Pragma("unroll") for (int k = 0; k < 2; ++k) dst[n][k] = *(const LAS bf16x8*)(lds + PG8_SB(b, h) + boff + n * 2048 + k * 1024); } while (0)
#define PG8_MMA(ai, bj, At, Bt) do { __builtin_amdgcn_s_setprio(1); _Pragma("unroll") for (int m = 0; m < 4; ++m) _Pragma("unroll") for (int n = 0; n < 2; ++n) _Pragma("unroll") for (int k = 0; k < 2; ++k) \
        acc[ai][bj][m][n] = __builtin_amdgcn_mfma_f32_16x16x32_bf16(Bt[n][k], At[m][k], acc[ai][bj][m][n], 0, 0, 0); __builtin_amdgcn_s_setprio(0); } while (0)
#define PG8_WAIT_V(n) asm volatile("s_waitcnt vmcnt(" #n ")" ::: "memory")
#define PG8_WAIT_L(n) asm volatile("s_waitcnt lgkmcnt(" #n ")" ::: "memory")
#define PG8_BAR __builtin_amdgcn_s_barrier()
#define PG8_SCHED __builtin_amdgcn_sched_barrier(0)
    GUnit cur, nxt; int ui = 0;
    if (!S.next(0, cur)) return;
    f32x4 acc[2][2][4][2];
#pragma unroll
    for (int a = 0; a < 2; ++a)
#pragma unroll
        for (int b = 0; b < 2; ++b)
#pragma unroll
            for (int m = 0; m < 4; ++m)
#pragma unroll
                for (int n = 0; n < 2; ++n) acc[a][b][m][n] = (f32x4){0.f, 0.f, 0.f, 0.f};
    bf16x8 At[4][2], B0[2][2], B1[2][2];
    const char* cA = cur.A; const char* cB = cur.B;
    asm volatile("" : "+s"(cA), "+s"(cB));
    PG8_STAGE(PG8_SB(0, 0), cB, voffB); PG8_STAGE(PG8_SA(0, 0), cA, voffA); PG8_STAGE(PG8_SB(0, 1), cB + hstepB, voffB); PG8_STAGE(PG8_SA(0, 1), cA + hstepA, voffA);
    if (wr == 1) PG8_BAR;
    PG8_WAIT_V(4); PG8_BAR;
    PG8_STAGE(PG8_SB(1, 0), cB + kstep, voffB); PG8_STAGE(PG8_SA(1, 0), cA + kstep, voffA); PG8_STAGE(PG8_SB(1, 1), cB + hstepB + kstep, voffB);
    PG8_WAIT_V(6); PG8_BAR;
    for (;;) {
        const bool has_next = S.next(ui + 1, nxt);
        const char* nA = has_next ? nxt.A : cA; const char* nB = has_next ? nxt.B : cB;
        asm volatile("" : "+s"(nA), "+s"(nB));
        const int nt = cur.nt;
        for (int t = 0; t < nt; t += 2) {
            const bool last = (t == nt - 2);
            const char* a1 = cA + (size_t)(t + 1) * kstep;
            const char* a2 = last ? nA : cA + (size_t)(t + 2) * kstep; const char* b2 = last ? nB : cB + (size_t)(t + 2) * kstep;
            const char* a3 = a2 + kstep; const char* b3 = b2 + kstep;
            PG8_LDB(B0, 0, 0); PG8_SCHED; PG8_LDA(At, 0, 0); PG8_STAGE(PG8_SA(1, 1), a1 + hstepA, voffA);
            PG8_WAIT_L(8); PG8_BAR; PG8_WAIT_L(0); PG8_MMA(0, 0, At, B0); PG8_BAR; PG8_SCHED;
            PG8_LDB(B1, 0, 1); PG8_STAGE(PG8_SB(0, 0), b2, voffB);
            PG8_BAR; PG8_WAIT_L(0); PG8_MMA(0, 1, At, B1); PG8_BAR;
            PG8_LDA(At, 0, 1); PG8_STAGE(PG8_SA(0, 0), a2, voffA);
            PG8_BAR; PG8_WAIT_L(0); PG8_MMA(1, 0, At, B0); PG8_BAR; PG8_SCHED;
            PG8_STAGE(PG8_SB(0, 1), b2 + hstepB, voffB);
            PG8_WAIT_V(6); PG8_BAR; PG8_MMA(1, 1, At, B1); PG8_BAR;
            PG8_LDB(B0, 1, 0); PG8_SCHED; PG8_LDA(At, 1, 0); PG8_STAGE(PG8_SA(0, 1), a2 + hstepA, voffA);
            PG8_WAIT_L(8); PG8_BAR; PG8_WAIT_L(0); PG8_MMA(0, 0, At, B0); PG8_BAR; PG8_SCHED;
            PG8_LDB(B1, 1, 1); PG8_STAGE(PG8_SB(1, 0), b3, voffB);
            PG8_BAR; PG8_WAIT_L(0); PG8_MMA(0, 1, At, B1); PG8_BAR;
            PG8_LDA(At, 1, 1); PG8_STAGE(PG8_SA(1, 0), a3, voffA);
            PG8_BAR; PG8_WAIT_L(0); PG8_MMA(1, 0, At, B0); PG8_BAR; PG8_SCHED;
            PG8_STAGE(PG8_SB(1, 1), b3 + hstepB, voffB);
            PG8_WAIT_V(6); PG8_BAR; PG8_MMA(1, 1, At, B1); PG8_BAR;
        }
        { const int t2 = ltid(wvid); const int w2 = __builtin_amdgcn_readfirstlane(t2 >> 6);
          E(acc, cur, w2 >> 2, w2 & 3, t2 & 15, (t2 >> 4) & 3); }
        if (!has_next) break;
#pragma unroll
        for (int a = 0; a < 2; ++a)
#pragma unroll
            for (int b = 0; b < 2; ++b)
#pragma unroll
                for (int m = 0; m < 4; ++m)
#pragma unroll
                    for (int n = 0; n < 2; ++n) acc[a][b][m][n] = (f32x4){0.f, 0.f, 0.f, 0.f};
        cur = nxt; cA = nA; cB = nB; ++ui;
    }
    PG8_WAIT_V(0);
    if (wr == 0) PG8_BAR;
    PG8_BAR;
#undef PG8_SA
#undef PG8_SB
#undef PG8_STAGE
#undef PG8_LDA
#undef PG8_LDB
#undef PG8_MMA
#undef PG8_WAIT_V
#undef PG8_WAIT_L
#undef PG8_BAR
#undef PG8_SCHED
}

#define EPI8_BEGIN _Pragma("unroll") for (int ai = 0; ai < 2; ++ai) _Pragma("unroll") for (int m = 0; m < 4; ++m) _Pragma("unroll") for (int bj = 0; bj < 2; ++bj) { \
    const int dr = ai * 128 + m * 16, dc = bj * 128, idx = (ai * 4 + m) * 2 + bj; const f32x4 v0 = acc[ai][bj][m][0], v1 = acc[ai][bj][m][1]; (void)dr; (void)dc; (void)idx;
#define EPI8_END asm volatile("" ::: "memory"); }

struct SchedG1 {
    int nM, nN, G, c; const char* A; const char* B;
    DI bool next(int i, GUnit& u) const {
        const int L = i * G + c; if (L >= nM * nN) return false;
        tile_order(L, nM, nN, u.pm, u.pn); u.sub = 0; u.nt = 16;
        u.A = A + (size_t)u.pm * 256 * 1024 * 2; u.B = B + (size_t)u.pn * 256 * 1024 * 2; return true;
    }
};
struct EpiG1 {
    unsigned char* ws; int layer;
    DI void operator()(const f32x4 (&acc)[2][2][4][2], const GUnit& u, int wr, int wc, int fr, int fq) const {
        const int rl0 = wr * 64 + fr, col0 = wc * 32 + 8 * fq, pm = u.pm, pn = u.pn;
        const bool lat = pm < 128; const int b = lat ? (pm >> 3) : (pm - 128);
        const int row0 = pm * 256 + rl0;
        if (pn == 7 || pn == 8) {
            float* Gp = (float*)(ws + OFF_G) + (size_t)(pn - 7) * TT * 256 + (size_t)row0 * 256 + col0;
            EPI8_BEGIN { float* d = Gp + (size_t)dr * 256 + dc; *(f32x4*)d = v0; *(f32x4*)(d + 4) = v1; } EPI8_END
        } else if (pn == 2 || pn == 5 || pn == 9 || pn == 10 || pn == 11) {
            bf16_t* base; int ldt, pos;
            if (pn >= 10) { const int part = pn - 10;
                if (lat) { base = (bf16_t*)(ws + OFF_FBL); ldt = 4096; pos = part * 2048 + (pm & 7) * 256 + rl0; }
                else { base = (bf16_t*)(ws + OFF_FBC); ldt = 512; pos = part * 256 + rl0; } }
            else { base = (bf16_t*)(ws + OFF_VT + (size_t)(pn == 2 ? 0 : pn == 5 ? 1 : 2) * SZ_VT); ldt = KEYS; pos = (lat ? (pm & 7) * 256 : SEQ) + rl0; }
            bf16_t* d0 = base + ((size_t)b * 256 + col0) * ldt + pos;
            EPI8_BEGIN { bf16_t* d = d0 + (size_t)dc * ldt + dr;
#pragma unroll
                for (int j = 0; j < 4; ++j) { d[(size_t)j * ldt] = f2bf(v0[j]); d[(size_t)(4 + j) * ldt] = f2bf(v1[j]); } } EPI8_END
        } else {
            bf16_t* d0; int ldn; bool act;
            if (pn == 6) { d0 = (bf16_t*)(ws + OFF_CQ) + col0; ldn = 256; act = true; }
            else if (pn >= 12) { d0 = (bf16_t*)(ws + OFF_YG) + (pn - 12) * 256 + col0; ldn = 1024; act = true; }
            else { d0 = (bf16_t*)(ws + OFF_ZQK) + (pn == 0 ? 0 : pn == 1 ? 256 : pn == 3 ? 512 : 768) + col0; ldn = 1024; act = false; }
            d0 += (size_t)row0 * ldn;
            if (act) { EPI8_BEGIN { u32x4 o; o.x = pack2(siluf(v0[0]), siluf(v0[1])); o.y = pack2(siluf(v0[2]), siluf(v0[3])); o.z = pack2(siluf(v1[0]), siluf(v1[1])); o.w = pack2(siluf(v1[2]), siluf(v1[3]));
                *(u32x4*)(d0 + (size_t)dr * ldn + dc) = o; } EPI8_END }
            else { EPI8_BEGIN { u32x4 o; o.x = pack2(v0[0], v0[1]); o.y = pack2(v0[2], v0[3]); o.z = pack2(v1[0], v1[1]); o.w = pack2(v1[2], v1[3]);
                *(u32x4*)(d0 + (size_t)dr * ldn + dc) = o; } EPI8_END }
        }
    }
};

struct SchedOne { GUnit u; DI bool next(int i, GUnit& o) const { if (i != 0) return false; o = u; return true; } };
struct EpiFour {
    bf16_t* Y; int rowbase;
    DI void operator()(const f32x4 (&acc)[2][2][4][2], const GUnit& u, int wr, int wc, int fr, int fq) const {
        const int r0 = rowbase + u.pm * 256 + wr * 64 + fr, c0 = 768 + wc * 32 + 8 * fq;
#pragma unroll
        for (int g8 = 0; g8 < 2; ++g8) {
            u32x4 gq[8];
#pragma unroll
            for (int q = 0; q < 8; ++q) { const int idx = g8 * 8 + q, ai = idx >> 3, m = (idx >> 1) & 3, bj = idx & 1; gq[q] = *(const u32x4*)(Y + (size_t)(r0 + ai * 128 + m * 16) * 1024 + c0 + bj * 128); }
#pragma unroll
            for (int q = 0; q < 8; ++q) { const int idx = g8 * 8 + q, ai = idx >> 3, m = (idx >> 1) & 3, bj = idx & 1; const f32x4 v0 = acc[ai][bj][m][0], v1 = acc[ai][bj][m][1]; const u32x4 g = gq[q]; u32x4 o;
                o.x = pack2(v0[0] * bflo(g.x), v0[1] * bfhi(g.x)); o.y = pack2(v0[2] * bflo(g.y), v0[3] * bfhi(g.y));
                o.z = pack2(v1[0] * bflo(g.z), v1[1] * bfhi(g.z)); o.w = pack2(v1[2] * bflo(g.w), v1[3] * bfhi(g.w));
                *(u32x4*)(Y + (size_t)(r0 + ai * 128 + m * 16) * 1024 + c0 + bj * 128) = o; }
            asm volatile("" ::: "memory");
        }
    }
};

struct SchedG2 {
    int nM, G, c; const char *YG, *WUP, *H, *WM;
    DI bool next(int i, GUnit& u) const {
        const int sup = i >> 3, sub = i & 7;
        if (sup < 2) {
            const int L = sup * G + c; if (L >= nM * 4) return false;
            tile_order(L, nM, 4, u.pm, u.pn); u.sub = sub; const int br = sub >> 1;
            if (!(sub & 1)) { u.nt = 4; u.A = YG + ((size_t)u.pm * 256 * 1024 + br * 256) * 2; u.B = WUP + ((size_t)u.pn * 256 * 1024 + br * 256) * 2; }
            else { u.nt = 16; u.A = H + (size_t)u.pm * 256 * 1024 * 2; u.B = WM + ((size_t)(br * 1024 + u.pn * 256) * 1024) * 2; }
            return true;
        }
        if (sup > 2 || sub > 1 || nM * 4 <= 2 * G) return false;
        const int L = 2 * G + (c & 63), br = c >> 6; tile_order(L, nM, 4, u.pm, u.pn); u.sub = 8 + sub;
        if (!sub) { u.nt = 4; u.A = YG + ((size_t)u.pm * 256 * 1024 + br * 256) * 2; u.B = WUP + ((size_t)u.pn * 256 * 1024 + br * 256) * 2; }
        else { u.nt = 16; u.A = H + (size_t)u.pm * 256 * 1024 * 2; u.B = WM + ((size_t)(br * 1024 + u.pn * 256) * 1024) * 2; }
        return true;
    }
};
struct EpiG2 {
    u32x4* brs; u32x4* accs; bf16_t* ACC; u32x4* t4;
    DI void operator()(const f32x4 (&acc)[2][2][4][2], const GUnit& u, int wr, int wc, int fr, int fq) const {
        const int tid = (wr * 4 + wc) * 64 + fq * 16 + fr; const int sub = u.sub;
        u32x4* B = brs + tid; u32x4* A = accs + tid;
        if (sub == 9) {
            u32x4* T = t4 + tid;
#pragma unroll
            for (int g8 = 0; g8 < 2; ++g8) {
                u32x4 bq[8];
#pragma unroll
                for (int q = 0; q < 8; ++q) bq[q] = B[(size_t)(g8 * 8 + q) * 512];
#pragma unroll
                for (int q = 0; q < 8; ++q) { const int idx = g8 * 8 + q, ai = idx >> 3, m = (idx >> 1) & 3, bj = idx & 1; const f32x4 v0 = acc[ai][bj][m][0], v1 = acc[ai][bj][m][1]; const u32x4 b = bq[q]; u32x4 o;
                    o.x = pack2(sigmoidf_(v0[0]) * bflo(b.x), sigmoidf_(v0[1]) * bfhi(b.x)); o.y = pack2(sigmoidf_(v0[2]) * bflo(b.y), sigmoidf_(v0[3]) * bfhi(b.y));
                    o.z = pack2(sigmoidf_(v1[0]) * bflo(b.z), sigmoidf_(v1[1]) * bfhi(b.z)); o.w = pack2(sigmoidf_(v1[2]) * bflo(b.w), sigmoidf_(v1[3]) * bfhi(b.w));
                    T[(size_t)idx * 512] = o; }
                asm volatile("" ::: "memory");
            }
        } else if (!(sub & 1)) {
            EPI8_BEGIN { u32x4 o; o.x = pack2(v0[0], v0[1]); o.y = pack2(v0[2], v0[3]); o.z = pack2(v1[0], v1[1]); o.w = pack2(v1[2], v1[3]); B[(size_t)idx * 512] = o; } EPI8_END
        } else {
            const int br = sub >> 1; const int row0 = u.pm * 256 + wr * 64 + fr, col0 = u.pn * 256 + wc * 32 + 8 * fq;
#pragma unroll
            for (int g8 = 0; g8 < 2; ++g8) {
                u32x4 bq[8], aq[8];
#pragma unroll
                for (int q = 0; q < 8; ++q) { bq[q] = B[(size_t)(g8 * 8 + q) * 512]; aq[q] = (u32x4){0u, 0u, 0u, 0u}; }
                if (br > 0) {
#pragma unroll
                    for (int q = 0; q < 8; ++q) aq[q] = A[(size_t)(g8 * 8 + q) * 512];
                }
#pragma unroll
                for (int q = 0; q < 8; ++q) {
                    const int idx = g8 * 8 + q, ai = idx >> 3, m = (idx >> 1) & 3, bj = idx & 1, dr = ai * 128 + m * 16, dc = bj * 128;
                    const f32x4 v0 = acc[ai][bj][m][0], v1 = acc[ai][bj][m][1]; const u32x4 b = bq[q], a = aq[q]; float t[8];
                    t[0] = sigmoidf_(v0[0]) * bflo(b.x) + bflo(a.x); t[1] = sigmoidf_(v0[1]) * bfhi(b.x) + bfhi(a.x); t[2] = sigmoidf_(v0[2]) * bflo(b.y) + bflo(a.y); t[3] = sigmoidf_(v0[3]) * bfhi(b.y) + bfhi(a.y);
                    t[4] = sigmoidf_(v1[0]) * bflo(b.z) + bflo(a.z); t[5] = sigmoidf_(v1[1]) * bfhi(b.z) + bfhi(a.z); t[6] = sigmoidf_(v1[2]) * bflo(b.w) + bflo(a.w); t[7] = sigmoidf_(v1[3]) * bfhi(b.w) + bfhi(a.w);
                    u32x4 o; o.x = pack2(t[0], t[1]); o.y = pack2(t[2], t[3]); o.z = pack2(t[4], t[5]); o.w = pack2(t[6], t[7]);
                    if (br < 3) A[(size_t)idx * 512] = o; else *(u32x4*)(ACC + (size_t)(row0 + dr) * 1024 + col0 + dc) = o;
                }
                asm volatile("" ::: "memory");
            }
        }
    }
};

struct SchedG3 {
    int nM, G, c; const char* A; const char* B;
    DI bool next(int i, GUnit& u) const {
        const int L = i * G + c; if (L >= nM * 4) return false;
        tile_order(L, nM, 4, u.pm, u.pn); u.sub = 0; u.nt = 16;
        u.A = A + (size_t)u.pm * 256 * 1024 * 2; u.B = B + (size_t)u.pn * 256 * 1024 * 2; return true;
    }
};
struct EpiG3 {
    Params p; int layer;
    DI void operator()(const f32x4 (&acc)[2][2][4][2], const GUnit& u, int wr, int wc, int fr, int fq) const {
        const int pm = u.pm; const int bi = pm < 128 ? (pm >> 3) : 16;
        const float* gate = (const float*)(p.k->ws + OFF_MOD) + ((size_t)layer * 17 + bi) * 3072 + 2048;
        const int row0 = pm * 256 + wr * 64 + fr, col0 = u.pn * 256 + wc * 32 + 8 * fq;
#pragma unroll
        for (int bj = 0; bj < 2; ++bj) { const int cc = col0 + bj * 128; const f32x4 g0 = *(const f32x4*)(gate + cc), g1 = *(const f32x4*)(gate + cc + 4);
            f32x4 x0[8], x1[8];
#pragma unroll
            for (int q = 0; q < 8; ++q) { const float* xi = xrow_in(p, layer, row0 + (q >> 2) * 128 + (q & 3) * 16) + cc; x0[q] = *(const f32x4*)xi; x1[q] = *(const f32x4*)(xi + 4); }
#pragma unroll
            for (int q = 0; q < 8; ++q) { float* xo = xrow(p, row0 + (q >> 2) * 128 + (q & 3) * 16) + cc;
                *(f32x4*)xo = x0[q] + g0 * acc[q >> 2][bj][q & 3][0]; *(f32x4*)(xo + 4) = x1[q] + g1 * acc[q >> 2][bj][q & 3][1]; }
            asm volatile("" ::: "memory"); }
    }
};

constexpr int KS_STRIDE = 144, VS_STRIDE = 136, KS_BYTES = 64 * KS_STRIDE, VS_BYTES = 64 * VS_STRIDE;
constexpr int LDS_KS = 0, LDS_VS = 2 * KS_BYTES, LDS_TB = LDS_VS + 2 * VS_BYTES;

template <bool SCALED>
DI void softmax16(f32x16& x, const float c, float& m, float& l, float& alpha, bf16x8& p0, bf16x8& p1) {
    float mx = x[0];
#pragma unroll
    for (int i = 1; i < 16; ++i) mx = fmaxf(mx, x[i]);
    mx = fmaxf(mx, __shfl_xor(mx, 32));
    const float mc = SCALED ? mx : mx * c;
    const float mn = (mc > m + 8.f) ? mc : m; alpha = __builtin_amdgcn_exp2f(m - mn); m = mn;
    float s = 0.f;
#pragma unroll
    for (int i = 0; i < 16; ++i) { x[i] = __builtin_amdgcn_exp2f(SCALED ? x[i] - mn : __builtin_fmaf(x[i], c, -mn)); s += x[i]; }
    l = l * alpha + s;
    p0 = pack8(x[0], x[1], x[2], x[3], x[4], x[5], x[6], x[7]); p1 = pack8(x[8], x[9], x[10], x[11], x[12], x[13], x[14], x[15]);
}

template <int MODE>
DI void attn_unit(LAS unsigned char* lds, const Params& p, int layer, int b, int h, int kind, int qrow0, int R) {
    const int tid = ltid(p.wvid), wv = tid >> 6, lane = tid & 63, l32 = lane & 31, hh = lane >> 5;
    const bf16_t* Z = (const bf16_t*)(p.k->ws + OFF_ZQK);
    const bf16_t* VT = (const bf16_t*)(p.k->ws + OFF_VT + (MODE == 0 ? 0 : SZ_VT)) + ((size_t)b * 256 + h * 64) * KEYS;
    bf16_t* Y = (bf16_t*)(p.k->ws + OFF_YG);
    const int qcol = (MODE == 0 ? 0 : 512) + h * 64, kcol = qcol + 256, ycol = (MODE == 0 ? 0 : 256) + h * 64;
    int lo = 0, ntile;
    if (kind == 0) ntile = 36; else if (kind == 1) ntile = 4;
    else { lo = min(max(4 * R - 4, 0), 24); const int hi = min(max(4 * R - 1, 0), 24) + 7; ntile = 4 + hi - lo + 1; }
    const float c = (MODE == 0 ? 0.17677669529663687f : 0.125f) * LOG2E;
    const int nrp = wv >> 2, ng = wv & 3, rq = 4 * R + 2 * nrp + (l32 >> 4), cq = 16 * ng + (l32 & 15);
    const int r0w = min(max(rq - 4, 0), 24), c0w = min(max(cq - 8, 0), 48);
    const int r0a = min(max(4 * R + 2 * nrp - 4, 0), 24), r0b = min(max(4 * R + 2 * nrp - 3, 0), 24);
    const int cs = ng == 0 ? 0 : ng == 1 ? 8 : ng == 2 ? 24 : 32;
    const bool na = (MODE == 1 && kind == 2);
    const int qtok = na ? b * SEQ + rq * 64 + cq : qrow0 + wv * 32 + l32;
    __syncthreads();
    if (MODE == 1 && kind == 2) { const float* rp = p.k->na_rpb + ((size_t)layer * 4 + h) * 15 * 31; for (int i = tid; i < 15 * 31; i += 512) *(LAS float*)(lds + LDS_TB + i * 4) = rp[i] * LOG2E; }
    bf16x8 qf[4];
    { const bf16_t* qp = Z + (size_t)qtok * 1024 + qcol + 8 * hh;
#pragma unroll
      for (int s = 0; s < 4; ++s) qf[s] = mk8u(*(const u32x4*)(qp + 16 * s)); }
    auto tile_src = [&](int t, const bf16_t*& kp, const bf16_t*& vp, int& mrow) {
        int krow, key; mrow = -1;
        if (kind == 0) { key = 64 * t; krow = t < 32 ? b * SEQ + 64 * t : TL + b * CTX + 64 * (t - 32); }
        else if (kind == 1 || t < 4) { key = SEQ + 64 * t; krow = TL + b * CTX + 64 * t; }
        else { mrow = lo + t - 4; key = 64 * mrow; krow = b * SEQ + key; }
        kp = Z + (size_t)krow * 1024 + kcol; vp = VT + key;
    };
    const int lr = tid >> 3, lc = tid & 7;
    u32x4 kreg, vreg; const bf16_t *kp, *vp; int mrow;
    tile_src(0, kp, vp, mrow);
    kreg = *(const u32x4*)(kp + (size_t)lr * 1024 + lc * 8); vreg = *(const u32x4*)(vp + (size_t)lr * KEYS + lc * 8);
    *(LAS u32x4*)(lds + LDS_KS + lr * KS_STRIDE + lc * 16) = kreg;
    { LAS u32x2* d = (LAS u32x2*)(lds + LDS_VS + lr * VS_STRIDE + lc * 16); d[0] = mku2(vreg.x, vreg.y); d[1] = mku2(vreg.z, vreg.w); }
    __syncthreads();
    f32x16 O1[2], O2[2]; O1[0] = zero16(); O1[1] = zero16(); O2[0] = zero16(); O2[1] = zero16();
    float m1 = -1e30f, l1 = 0.f, m2 = -1e30f, l2 = 0.f;
    for (int t = 0; t < ntile; ++t) {
        const int buf = t & 1; int mr_cur = mrow;
        if (t + 1 < ntile) { tile_src(t + 1, kp, vp, mrow); kreg = *(const u32x4*)(kp + (size_t)lr * 1024 + lc * 8); vreg = *(const u32x4*)(vp + (size_t)lr * KEYS + lc * 8); }
        bool active = true;
        if (MODE == 1 && mr_cur >= 0) active = (mr_cur >= r0a) && (mr_cur < r0b + 8);
        const int nkt = (MODE == 1 && mr_cur >= 0) ? 1 : 2;
        if (active) {
#pragma unroll 2
            for (int kt = 0; kt < nkt; ++kt) {
                const int koff = (MODE == 1 && mr_cur >= 0) ? cs : kt * 32;
                bf16x8 kf[4];
                { const LAS unsigned char* kb = lds + LDS_KS + buf * KS_BYTES + (koff + l32) * KS_STRIDE + 16 * hh;
#pragma unroll
                  for (int s = 0; s < 4; ++s) kf[s] = *(const LAS bf16x8*)(kb + 32 * s); }
                bf16x8 vf[2][2];
#pragma unroll
                for (int mt = 0; mt < 2; ++mt)
#pragma unroll
                    for (int sp = 0; sp < 2; ++sp) { const LAS unsigned char* vb = lds + LDS_VS + buf * VS_BYTES + (mt * 32 + l32) * VS_STRIDE + (koff + 16 * sp + 4 * hh) * 2;
                        vf[mt][sp] = mk8(*(const LAS u32x2*)vb, *(const LAS u32x2*)(vb + 16)); }
                if (MODE == 0) {
                    f32x16 s1 = MFMA32(kf[0], qf[0], zero16()); s1 = MFMA32(kf[1], qf[1], s1);
                    f32x16 s2 = MFMA32(kf[2], qf[2], zero16()); s2 = MFMA32(kf[3], qf[3], s2);
                    float a1, a2; bf16x8 p1[2], p2[2];
                    softmax16<false>(s1, c, m1, l1, a1, p1[0], p1[1]); softmax16<false>(s2, c, m2, l2, a2, p2[0], p2[1]);
                    const bool resc = __any((a1 != 1.f) || (a2 != 1.f));
#pragma unroll
                    for (int mt = 0; mt < 2; ++mt) {
                        if (resc) {
#pragma unroll
                            for (int i = 0; i < 16; ++i) { O1[mt][i] *= a1; O2[mt][i] *= a2; }
                        }
#pragma unroll
                        for (int sp = 0; sp < 2; ++sp) { O1[mt] = MFMA32(vf[mt][sp], p1[sp], O1[mt]); O2[mt] = MFMA32(vf[mt][sp], p2[sp], O2[mt]); }
                    }
                } else {
                    f32x16 s1 = MFMA32(kf[0], qf[0], zero16()); s1 = MFMA32(kf[1], qf[1], s1); s1 = MFMA32(kf[2], qf[2], s1); s1 = MFMA32(kf[3], qf[3], s1);
                    if (mr_cur >= 0) {
                        const int brow = min(max(mr_cur - rq + 7, 0), 14) * 31; const bool rv = (mr_cur >= r0w) && (mr_cur < r0w + 8);
#pragma unroll
                        for (int i = 0; i < 16; ++i) { const int kc = koff + crow(i, hh); const bool in = rv && (kc >= c0w) && (kc < c0w + 16);
                            const int bi = brow + min(max(kc - cq, -15), 15) + 15;
                            const float bv = *(const LAS float*)(lds + LDS_TB + bi * 4);
                            s1[i] = in ? s1[i] * c + bv : -1e30f; }
                    }
                    float a1; bf16x8 p1[2];
                    if (mr_cur >= 0) softmax16<true>(s1, c, m1, l1, a1, p1[0], p1[1]); else softmax16<false>(s1, c, m1, l1, a1, p1[0], p1[1]);
                    const bool resc = __any(a1 != 1.f);
#pragma unroll
                    for (int mt = 0; mt < 2; ++mt) {
                        if (resc) {
#pragma unroll
                            for (int i = 0; i < 16; ++i) O1[mt][i] *= a1;
                        }
#pragma unroll
                        for (int sp = 0; sp < 2; ++sp) O1[mt] = MFMA32(vf[mt][sp], p1[sp], O1[mt]);
                    }
                }
            }
        }
        if (t + 1 < ntile) {
            const int nb = buf ^ 1;
            *(LAS u32x4*)(lds + LDS_KS + nb * KS_BYTES + lr * KS_STRIDE + lc * 16) = kreg;
            LAS u32x2* d = (LAS u32x2*)(lds + LDS_VS + nb * VS_BYTES + lr * VS_STRIDE + lc * 16); d[0] = mku2(vreg.x, vreg.y); d[1] = mku2(vreg.z, vreg.w);
        }
        __syncthreads();
    }
    const float i1 = 1.f / (l1 + __shfl_xor(l1, 32));
    float post = 1.f; const float* gain = nullptr; float lam = 0.f, i2 = 0.f;
    if (MODE == 0) { i2 = 1.f / (l2 + __shfl_xor(l2, 32)); lam = ((const float*)(p.k->ws + OFF_MISC))[MISC_LAM + layer];
        const float lam_init = 0.8f - 0.6f * __expf(-0.3f * (float)layer); post = 1.f - lam_init; gain = p.k->da_subln_gain + layer * 64; }
    float ss = 0.f;
#pragma unroll
    for (int mt = 0; mt < 2; ++mt)
#pragma unroll
        for (int i = 0; i < 16; ++i) { float o = O1[mt][i] * i1; if (MODE == 0) o -= lam * O2[mt][i] * i2; O1[mt][i] = o; ss += o * o; }
    float rn = 1.f;
    if (MODE == 0) { ss += __shfl_xor(ss, 32); rn = rsqrtf(ss * (1.f / 64.f) + EPS) * post; }
    bf16_t* yr = Y + (size_t)qtok * 1024 + ycol;
#pragma unroll
    for (int mt = 0; mt < 2; ++mt)
#pragma unroll
        for (int g = 0; g < 4; ++g) { const int dv = 32 * mt + 8 * g + 4 * hh; u32x2* d = (u32x2*)(yr + dv); const u32x2 sg = *d;
            float o0 = O1[mt][4 * g] * rn, o1 = O1[mt][4 * g + 1] * rn, o2 = O1[mt][4 * g + 2] * rn, o3 = O1[mt][4 * g + 3] * rn;
            if (MODE == 0) { const f32x4 gv = *(const f32x4*)(gain + dv); o0 *= gv[0]; o1 *= gv[1]; o2 *= gv[2]; o3 *= gv[3]; }
            u32x2 o; o.x = pack2(o0 * bflo(sg.x), o1 * bfhi(sg.x)); o.y = pack2(o2 * bflo(sg.y), o3 * bfhi(sg.y)); *d = o; }
}

constexpr int HG_STRIDE = 136, HG_TILE = 64 * HG_STRIDE, HG_ITEM = 4 * HG_TILE, HG_EV = 2 * HG_ITEM;
DI void hgrn_item(LAS unsigned char* lds, const Params& p, int item, int islot, int wq, int lane) {
    const int b = item >> 3, h = (item >> 1) & 3, dir = item & 1, tt = wq >> 1, et = wq & 1, l32 = lane & 31, hh = lane >> 5;
    unsigned* QK = (unsigned*)(p.k->ws + OFF_G) + (size_t)dir * TT * 256 + h * 64;
    const bf16_t* KLT = (const bf16_t*)(p.k->ws + OFF_KDT) + (((size_t)dir * NB + b) * 256 + h * 64) * KEYS;
    const bf16_t* VIT = (const bf16_t*)(p.k->ws + OFF_VT + 2 * SZ_VT) + ((size_t)b * 256 + h * 64) * KEYS;
    const float* EVB = (const float*)(p.k->ws + OFF_EV) + ((size_t)dir * NB + b) * NSLOT * 3 * 256 + h * 64;
    LAS unsigned char* tl = lds + islot * HG_ITEM;
    LAS float* evl = (LAS float*)(lds + HG_EV + islot * (NSLOT * 128 * 4));
    const int t256 = wq * 64 + lane, lrow = t256 >> 3, lc = t256 & 7;
    auto chunk_pos = [&](int j, int& row0, int& kbase) {
        if (j < 4) { const int jj = dir ? 3 - j : j; row0 = TL + b * CTX + 64 * jj; kbase = SEQ + 64 * jj; }
        else { const int jj = dir ? 31 - (j - 4) : j - 4; row0 = b * SEQ + 64 * jj; kbase = 64 * jj; } };
    u32x4 pre[4][2];
    auto issue = [&](int j) { int row0, kbase; chunk_pos(j, row0, kbase);
#pragma unroll
        for (int ps = 0; ps < 2; ++ps) { const int r = lrow + 32 * ps;
            pre[0][ps] = *(const u32x4*)(QK + (size_t)(row0 + r) * 256 + lc * 4); pre[1][ps] = *(const u32x4*)(QK + (size_t)(row0 + r) * 256 + 32 + lc * 4);
            pre[2][ps] = *(const u32x4*)(KLT + (size_t)r * KEYS + kbase + lc * 8); pre[3][ps] = *(const u32x4*)(VIT + (size_t)r * KEYS + kbase + lc * 8); } };
    auto commit = [&]() {
#pragma unroll
        for (int ps = 0; ps < 2; ++ps) { const int r = lrow + 32 * ps;
#pragma unroll
            for (int k = 0; k < 2; ++k) { const u32x4 x = pre[k][ps];
                const unsigned q01 = (x.x & 0xffffu) | (x.y << 16), q23 = (x.z & 0xffffu) | (x.w << 16), k01 = (x.x >> 16) | (x.y & 0xffff0000u), k23 = (x.z >> 16) | (x.w & 0xffff0000u);
                *(LAS u32x2*)(tl + 0 * HG_TILE + r * HG_STRIDE + (32 * k + 4 * lc) * 2) = mku2(q01, q23);
                *(LAS u32x2*)(tl + 1 * HG_TILE + r * HG_STRIDE + (32 * k + 4 * lc) * 2) = mku2(k01, k23); }
#pragma unroll
            for (int t = 2; t < 4; ++t) { LAS u32x2* d = (LAS u32x2*)(tl + t * HG_TILE + r * HG_STRIDE + lc * 16); d[0] = mku2(pre[t][ps].x, pre[t][ps].y); d[1] = mku2(pre[t][ps].z, pre[t][ps].w); } } };
    __syncthreads();
    for (int i = t256; i < NSLOT * 128; i += 256) { const int sl = i >> 7, r = i & 127; evl[i] = EVB[(size_t)sl * 3 * 256 + (r >> 6) * 256 + (r & 63)]; }
    issue(0); commit();
    __syncthreads();
    f32x16 S[2]; S[0] = zero16(); S[1] = zero16();
    auto frag = [&](int tile, int row, int col) { const LAS unsigned char* a = tl + tile * HG_TILE + row * HG_STRIDE + (col + 4 * hh) * 2; return mk8(*(const LAS u32x2*)a, *(const LAS u32x2*)(a + 16)); };
    for (int j = 0; j < NSLOT; ++j) {
        int row0, kbase; chunk_pos(j, row0, kbase);
        if (j + 1 < NSLOT) issue(j + 1);
        const LAS float* ev = evl + (kbase >> 6) * 128 + 4 * hh;
        bf16x8 qp[2][2], vp[2][2];
#pragma unroll
        for (int dt = 0; dt < 2; ++dt)
#pragma unroll
            for (int sp = 0; sp < 2; ++sp) { qp[dt][sp] = frag(0, 32 * tt + l32, 32 * dt + 16 * sp); vp[dt][sp] = frag(3, 32 * et + l32, 32 * dt + 16 * sp); }
        f32x16 o = zero16();
        const int tau = 32 * tt + l32;
#pragma unroll
        for (int st = 0; st < 2; ++st) {
            f32x16 a = zero16();
#pragma unroll
            for (int dt = 0; dt < 2; ++dt)
#pragma unroll
                for (int sp = 0; sp < 2; ++sp) a = MFMA32(frag(1, 32 * st + l32, 32 * dt + 16 * sp), qp[dt][sp], a);
#pragma unroll
            for (int i = 0; i < 16; ++i) { const int sg = 32 * st + crow(i, hh); const bool keep = dir == 0 ? (sg <= tau) : (sg >= tau); a[i] = keep ? a[i] : 0.f; }
#pragma unroll
            for (int sp = 0; sp < 2; ++sp)
                o = MFMA32(pack8(a[8 * sp], a[8 * sp + 1], a[8 * sp + 2], a[8 * sp + 3], a[8 * sp + 4], a[8 * sp + 5], a[8 * sp + 6], a[8 * sp + 7]), vp[st][sp], o);
        }
#pragma unroll
        for (int dt = 0; dt < 2; ++dt) {
            float em[16];
#pragma unroll
            for (int g = 0; g < 4; ++g) { const f32x4 e4 = *(const LAS f32x4*)(ev + 64 + 32 * dt + 8 * g); em[4 * g] = e4[0]; em[4 * g + 1] = e4[1]; em[4 * g + 2] = e4[2]; em[4 * g + 3] = e4[3]; }
#pragma unroll
            for (int sp = 0; sp < 2; ++sp)
                o = MFMA32(qp[dt][sp], pack8(S[dt][8 * sp] * em[8 * sp], S[dt][8 * sp + 1] * em[8 * sp + 1], S[dt][8 * sp + 2] * em[8 * sp + 2], S[dt][8 * sp + 3] * em[8 * sp + 3],
                                             S[dt][8 * sp + 4] * em[8 * sp + 4], S[dt][8 * sp + 5] * em[8 * sp + 5], S[dt][8 * sp + 6] * em[8 * sp + 6], S[dt][8 * sp + 7] * em[8 * sp + 7]), o);
        }
#pragma unroll
        for (int i = 0; i < 16; ++i) ((bf16_t*)(QK + (size_t)(row0 + 32 * tt + crow(i, hh)) * 256 + 32 * et + l32))[0] = f2bf(o[i]);
#pragma unroll
        for (int dt = 0; dt < 2; ++dt) {
            f32x16 tmp = zero16();
#pragma unroll
            for (int st = 0; st < 2; ++st)
#pragma unroll
                for (int sp = 0; sp < 2; ++sp) tmp = MFMA32(frag(2, 32 * dt + l32, 32 * st + 16 * sp), vp[st][sp], tmp);
#pragma unroll
            for (int g = 0; g < 4; ++g) { const f32x4 eb = *(const LAS f32x4*)(ev + 32 * dt + 8 * g);
#pragma unroll
                for (int jj = 0; jj < 4; ++jj) S[dt][4 * g + jj] = eb[jj] * S[dt][4 * g + jj] + tmp[4 * g + jj]; }
        }
        __syncthreads();
        if (j + 1 < NSLOT) commit();
        __syncthreads();
    }
}

DI void phase_h(const Params& p, int layer) {
    const int lane = ltid(p.wvid) & 63, wv = ltid(p.wvid) >> 6;
    bf16_t* H = (bf16_t*)(p.k->ws + OFF_H); const float* ng = p.k->norm_gain + layer * DM;
    const int stride = gridDim.x * 8;
    for (int rowa = lbid() * 8 + wv; rowa < TT; rowa += 2 * stride) {
        f32x4 v[2][4];
#pragma unroll
        for (int r2 = 0; r2 < 2; ++r2) { const int row = rowa + r2 * stride; if (row < TT) { const float* xr = xrow_in(p, layer, row);
#pragma unroll
            for (int k = 0; k < 4; ++k) v[r2][k] = *(const f32x4*)(xr + k * 256 + lane * 4); } }
#pragma unroll
        for (int r2 = 0; r2 < 2; ++r2) { const int row = rowa + r2 * stride; if (row < TT) {
            const int bi = row < TL ? row / SEQ : 16;
            const float* mod = (const float*)(p.k->ws + OFF_MOD) + ((size_t)layer * 17 + bi) * 3072;
            float ss = 0.f;
#pragma unroll
            for (int k = 0; k < 4; ++k) ss += v[r2][k][0] * v[r2][k][0] + v[r2][k][1] * v[r2][k][1] + v[r2][k][2] * v[r2][k][2] + v[r2][k][3] * v[r2][k][3];
#pragma unroll
            for (int o = 32; o > 0; o >>= 1) ss += __shfl_xor(ss, o);
            const float r = rsqrtf(ss * (1.f / DM) + EPS);
#pragma unroll
            for (int k = 0; k < 4; ++k) { const int cc = k * 256 + lane * 4; const f32x4 g = *(const f32x4*)(ng + cc), sh = *(const f32x4*)(mod + cc), sc = *(const f32x4*)(mod + 1024 + cc);
                float o[4];
#pragma unroll
                for (int j = 0; j < 4; ++j) o[j] = v[r2][k][j] * r * g[j] * (1.f + sc[j]) + sh[j];
                u32x2 w; w.x = pack2(o[0], o[1]); w.y = pack2(o[2], o[3]); *(u32x2*)(H + (size_t)row * 1024 + cc) = w; } } }
    }
}

DI void tconv_tile(LAS unsigned char* lds, const int wvid, const float* src, int lds_src, bf16_t* dst, int ldd) {
    LAS float* t = (LAS float*)lds; const int tid = ltid(wvid);
    __syncthreads();
    { const int r = tid >> 4, c4 = (tid & 15) * 4;
#pragma unroll
      for (int rr = 0; rr < 2; ++rr) { const f32x4 v = *(const f32x4*)(src + (size_t)(r + 32 * rr) * lds_src + c4);
#pragma unroll
          for (int j = 0; j < 4; ++j) t[(r + 32 * rr) * 65 + c4 + j] = v[j]; } }
    __syncthreads();
    { const int n = tid >> 3, k0 = (tid & 7) * 8; u32x4 o;
      o.x = pack2(t[(k0) * 65 + n], t[(k0 + 1) * 65 + n]); o.y = pack2(t[(k0 + 2) * 65 + n], t[(k0 + 3) * 65 + n]);
      o.z = pack2(t[(k0 + 4) * 65 + n], t[(k0 + 5) * 65 + n]); o.w = pack2(t[(k0 + 6) * 65 + n], t[(k0 + 7) * 65 + n]);
      *(u32x4*)(dst + (size_t)n * ldd + k0) = o; }
}

DI void phase_weights(LAS unsigned char* lds, const Params& p, int layer, int jstart, int jstep) {
    unsigned char* wb = p.k->ws + wsel(layer);
    bf16_t* WIN = (bf16_t*)(wb + OFF_WIN); bf16_t* WUP = (bf16_t*)(wb + OFF_WUP); bf16_t* WM = (bf16_t*)(wb + OFF_WM); bf16_t* WO = (bf16_t*)(wb + OFF_WO);
    const float* win = p.k->w_in + (size_t)layer * 1024 * 3840; const float* wup = p.k->w_up + (size_t)layer * 4 * 256 * 1024;
    const float* wm = p.k->w_merge + (size_t)layer * 4 * 1024 * 1024; const float* wo = p.k->w_out + (size_t)layer * 1024 * 1024;
    constexpr int J_IN = 16 * 56, J_UP = 4 * 4 * 16, J_M = 4 * 16 * 16, J_O = 16 * 16, J_F = 64;
    constexpr int NJ = J_IN + J_UP + J_M + J_O + J_F;
    for (int job = jstart; job < NJ; job += jstep) {
        int j = job;
        if (j < J_IN) { const int kt = j / 56; int nt = j % 56; if (nt >= 40) nt += 4; const int n0 = nt * 64; const int dn = n0 < 2560 ? n0 : n0 + 256;
            tconv_tile(lds, p.wvid, win + (size_t)kt * 64 * 3840 + n0, 3840, WIN + (size_t)dn * 1024 + kt * 64, 1024); continue; }
        j -= J_IN;
        if (j < J_UP) { const int i = j / 64, kt = (j % 64) / 16, nt = j % 16;
            tconv_tile(lds, p.wvid, wup + (size_t)i * 256 * 1024 + (size_t)kt * 64 * 1024 + nt * 64, 1024, WUP + (size_t)nt * 64 * 1024 + i * 256 + kt * 64, 1024); continue; }
        j -= J_UP;
        if (j < J_M) { const int i = j / 256, kt = (j % 256) / 16, nt = j % 16;
            tconv_tile(lds, p.wvid, wm + (size_t)i * 1024 * 1024 + (size_t)kt * 64 * 1024 + nt * 64, 1024, WM + ((size_t)i * 1024 + nt * 64) * 1024 + kt * 64, 1024); continue; }
        j -= J_M;
        if (j < J_O) { const int kt = j / 16, nt = j % 16; tconv_tile(lds, p.wvid, wo + (size_t)kt * 64 * 1024 + nt * 64, 1024, WO + (size_t)nt * 64 * 1024 + kt * 64, 1024); continue; }
        j -= J_O;
        {
            const int kt = j >> 2, g = j & 3; LAS float* t = (LAS float*)lds; LAS float* cs = t + 64 * 65; const int tid = ltid(p.wvid);
            __syncthreads();
            { const int r = tid >> 4, c4 = (tid & 15) * 4;
#pragma unroll
              for (int rr = 0; rr < 2; ++rr) { const f32x4 v = *(const f32x4*)(win + (size_t)(kt * 64 + r + 32 * rr) * 3840 + 2560 + g * 64 + c4);
#pragma unroll
                  for (int jj = 0; jj < 4; ++jj) t[(r + 32 * rr) * 65 + c4 + jj] = v[jj]; } }
            if (tid < 64) { cs[tid] = cospif((float)tid * (1.f / 32.f)) * 0.125f; cs[64 + tid] = sinpif((float)tid * (1.f / 32.f)) * 0.125f; }
            __syncthreads();
            const int cp = tid & 63, kg = tid >> 6; float ac[8], as[8];
#pragma unroll
            for (int k = 0; k < 8; ++k) { ac[k] = 0.f; as[k] = 0.f; }
            for (int cch = 0; cch < 64; ++cch) { const int a = (cch * cp) & 63; const float cv = cs[a], sv = cs[64 + a];
#pragma unroll
                for (int k = 0; k < 8; ++k) { const float w = t[(kg * 8 + k) * 65 + cch]; ac[k] += w * cv; as[k] += w * sv; } }
            u32x4 o; o.x = pack2(ac[0], ac[1]); o.y = pack2(ac[2], ac[3]); o.z = pack2(ac[4], ac[5]); o.w = pack2(ac[6], ac[7]);
            *(u32x4*)(WIN + (size_t)(2560 + g * 64 + cp) * 1024 + kt * 64 + kg * 8) = o;
            o.x = pack2(as[0], as[1]); o.y = pack2(as[2], as[3]); o.z = pack2(as[4], as[5]); o.w = pack2(as[6], as[7]);
            *(u32x4*)(WIN + (size_t)(2816 + g * 64 + cp) * 1024 + kt * 64 + kg * 8) = o;
        }
    }
}

DI void phase_pro(LAS unsigned char* lds, const Params& p) {
    const int tid = ltid(p.wvid); const size_t gt = (size_t)lbid() * 512 + tid, gs = (size_t)gridDim.x * 512;
    float* misc = (float*)(p.k->ws + OFF_MISC);
    if (lbid() == 0) {
        { const int dir = tid >> 8, ch = tid & 255; float lg[4], mx = -1e30f;
          for (int l = 0; l < 4; ++l) { lg[l] = p.k->hg_lb_logits[(dir * 4 + l) * 256 + ch]; mx = fmaxf(mx, lg[l]); }
          float s = 0.f; for (int l = 0; l < 4; ++l) { lg[l] = expf(lg[l] - mx); s += lg[l]; }
          float cum = 0.f;
          for (int l = 0; l < 4; ++l) { if (l > 0) cum += lg[l] / s; const float lb = cum;
              misc[MISC_LOGLB + (dir * 4 + l) * 256 + ch] = logf(fmaxf(lb, 1e-20f)); misc[MISC_LOG1M + (dir * 4 + l) * 256 + ch] = log1pf(-lb); } }
        if (tid < 4) { const float* lv = p.k->da_lambda + tid * 4 * 32; float s0 = 0.f, s1 = 0.f; for (int i = 0; i < 32; ++i) { s0 += lv[i] * lv[32 + i]; s1 += lv[64 + i] * lv[96 + i]; }
            misc[MISC_LAM + tid] = expf(s0) - expf(s1) + (0.8f - 0.6f * expf(-0.3f * (float)tid)); }
        if (tid < 8) ((int*)misc)[MISC_CTR + tid] = 0;
    }
    { float* rp = (float*)(p.k->ws + OFF_ROPE);
      for (size_t i = gt; i < (size_t)2048 * 16; i += gs) { const int n = (int)(i >> 4), j = (int)(i & 15); const float inv = exp2f(-(float)(j & 7) * 1.6609640474436813f);
          const float ang = (float)(j < 8 ? (n >> 6) : (n & 63)) * inv; float sn, cs; sincosf(ang, &sn, &cs); rp[n * 32 + j] = cs; rp[n * 32 + 16 + j] = sn; } }
    { bf16_t* AL = (bf16_t*)(p.k->ws + OFF_DFTL); const float sl = 0.022097086912079608f;
      for (size_t i = gt; i < (size_t)2048 * 4096 / 8; i += gs) { const int n = (int)(i >> 9), k0 = (int)(i & 511) * 8; float v[8];
#pragma unroll
          for (int j = 0; j < 8; ++j) { const int kk = k0 + j; const int k = kk & 2047; const int r = (n * k) & 2047; const float a = (float)r * (1.f / 1024.f); v[j] = (kk < 2048 ? cospif(a) : -sinpif(a)) * sl; }
          *(u32x4*)(AL + i * 8) = __builtin_bit_cast(u32x4, pack8(v[0], v[1], v[2], v[3], v[4], v[5], v[6], v[7])); }
      bf16_t* AC = (bf16_t*)(p.k->ws + OFF_DFTC);
      for (size_t i = gt; i < (size_t)256 * 512 / 8; i += gs) { const int n = (int)(i >> 6), k0 = (int)(i & 63) * 8; float v[8];
#pragma unroll
          for (int j = 0; j < 8; ++j) { const int kk = k0 + j; const int k = kk & 255; const int r = (n * k) & 255; const float a = (float)r * (1.f / 128.f); v[j] = (kk < 256 ? cospif(a) : -sinpif(a)) * 0.0625f; }
          *(u32x4*)(AC + i * 8) = __builtin_bit_cast(u32x4, pack8(v[0], v[1], v[2], v[3], v[4], v[5], v[6], v[7])); } }
    { LAS float* sc = (LAS float*)lds;
      LAS float* red = sc + 17 * 1024;
      __syncthreads();
      for (int i = tid; i < 17 * 1024; i += 512) { const int r = i >> 10, k = i & 1023; const float v = r < 16 ? p.k->c[r * 1024 + k] : p.k->c_ctx[k]; sc[i] = v / (1.f + expf(-v)); }
      __syncthreads();
      const int wv = tid >> 6, lane = tid & 63;
      for (int job = lbid(); job < 4 * 48; job += gridDim.x) {
          const int l = job / 48, col = (job % 48) * 64 + lane; const float* w = p.k->w_mod + (size_t)l * 1024 * 3072 + col;
          float a[17];
#pragma unroll
          for (int r = 0; r < 17; ++r) a[r] = 0.f;
          for (int k0 = wv * 128; k0 < wv * 128 + 128; k0 += 16) {
              float wq[16];
#pragma unroll
              for (int q = 0; q < 16; ++q) wq[q] = w[(size_t)(k0 + q) * 3072];
#pragma unroll
              for (int q = 0; q < 16; ++q) {
#pragma unroll
                  for (int r = 0; r < 17; ++r) a[r] += sc[r * 1024 + k0 + q] * wq[q]; } }
#pragma unroll
          for (int r = 0; r < 17; ++r) red[(wv * 17 + r) * 64 + lane] = a[r];
          __syncthreads();
          for (int i = tid; i < 17 * 64; i += 512) { const int r = i >> 6, ln = i & 63; float s = 0.f;
#pragma unroll
              for (int w8 = 0; w8 < 8; ++w8) s += red[(w8 * 17 + r) * 64 + ln];
              const int cc = (job % 48) * 64 + ln; ((float*)(p.k->ws + OFF_MOD))[((size_t)l * 17 + r) * 3072 + cc] = s + p.k->b_mod[l * 3072 + cc]; }
          __syncthreads();
      } }
}

DI void phase_prep(LAS unsigned char* lds, const Params& p, int layer) {
    const int tid = ltid(p.wvid), lane = tid & 63, wv = tid >> 6;
    bf16_t* Z = (bf16_t*)(p.k->ws + OFF_ZQK);
    { const bool isA = lane < 32; const bool isK = isA ? (lane >= 16) : (lane >= 48);
      const float* gptr = isA ? p.k->da_qk_gain + (layer * 2 + (isK ? 1 : 0)) * 32 + (lane & 1) * 16 : p.k->na_qk_gain + (layer * 2 + (isK ? 1 : 0)) * 64 + (lane & 3) * 16;
      float gn[16];
#pragma unroll
      for (int j = 0; j < 16; ++j) gn[j] = gptr[j];
      const int stride = gridDim.x * 8;
      for (int rowa = lbid() * 8 + wv; rowa < TT; rowa += 2 * stride) {
          u32x4 ua[2][2];
#pragma unroll
          for (int r2 = 0; r2 < 2; ++r2) { const int row = rowa + r2 * stride; if (row < TT) { const u32x4* zq = (const u32x4*)(Z + (size_t)row * 1024 + lane * 16); ua[r2][0] = zq[0]; ua[r2][1] = zq[1]; } }
#pragma unroll
          for (int r2 = 0; r2 < 2; ++r2) { const int row = rowa + r2 * stride; if (row < TT) {
          u32x4* zp = (u32x4*)(Z + (size_t)row * 1024 + lane * 16); const u32x4 u0 = ua[r2][0], u1 = ua[r2][1];
          float v[16]; v[0] = bflo(u0.x); v[1] = bfhi(u0.x); v[2] = bflo(u0.y); v[3] = bfhi(u0.y); v[4] = bflo(u0.z); v[5] = bfhi(u0.z); v[6] = bflo(u0.w); v[7] = bfhi(u0.w);
          v[8] = bflo(u1.x); v[9] = bfhi(u1.x); v[10] = bflo(u1.y); v[11] = bfhi(u1.y); v[12] = bflo(u1.z); v[13] = bfhi(u1.z); v[14] = bflo(u1.w); v[15] = bfhi(u1.w);
          float ss = 0.f;
#pragma unroll
          for (int j = 0; j < 16; ++j) ss += v[j] * v[j];
          ss += __shfl_xor(ss, 1); const float ss2 = ss + __shfl_xor(ss, 2);
          const float r = isA ? rsqrtf(ss * (1.f / 32.f) + EPS) : rsqrtf(ss2 * (1.f / 64.f) + EPS);
#pragma unroll
          for (int j = 0; j < 16; ++j) v[j] = v[j] * r * gn[j];
          const bool rope = isA && row < TL;
          const int n = row & (SEQ - 1); const float* rt = (const float*)(p.k->ws + OFF_ROPE) + n * 32;
          float cs[16], sn[16];
#pragma unroll
          for (int j4 = 0; j4 < 4; ++j4) { f32x4 c4 = {1.f, 1.f, 1.f, 1.f}, s4 = {0.f, 0.f, 0.f, 0.f}; if (rope) { c4 = *(const f32x4*)(rt + 4 * j4); s4 = *(const f32x4*)(rt + 16 + 4 * j4); }
#pragma unroll
              for (int j = 0; j < 4; ++j) { cs[4 * j4 + j] = c4[j]; sn[4 * j4 + j] = s4[j]; } }
#pragma unroll
          for (int j = 0; j < 16; ++j) { const float other = __shfl_xor(v[j], 1);
              v[j] = (lane & 1) ? (other * sn[j] + v[j] * cs[j]) : (v[j] * cs[j] - other * sn[j]); }
          u32x4 o0, o1; o0.x = pack2(v[0], v[1]); o0.y = pack2(v[2], v[3]); o0.z = pack2(v[4], v[5]); o0.w = pack2(v[6], v[7]);
          o1.x = pack2(v[8], v[9]); o1.y = pack2(v[10], v[11]); o1.z = pack2(v[12], v[13]); o1.w = pack2(v[14], v[15]); zp[0] = o0; zp[1] = o1;
          } }
      } }
    { const bf16_t* CQ = (const bf16_t*)(p.k->ws + OFF_CQ); LAS float* part = (LAS float*)lds;
      const int ch = tid & 255, hf = tid >> 8;
      for (int item = lbid(); item < NB * NSLOT * 2; item += gridDim.x) {
          const int dir = item & 1, slot = (item >> 1) % NSLOT, b = (item >> 1) / NSLOT;
          const int row0 = slot < 32 ? b * SEQ + 64 * slot : TL + b * CTX + 64 * (slot - 32);
          float* G = (float*)(p.k->ws + OFF_G) + (size_t)dir * TT * 256 + (size_t)row0 * 256 + ch;
          const float* misc = (const float*)(p.k->ws + OFF_MISC);
          const float lbv = __expf(misc[MISC_LOGLB + (dir * 4 + layer) * 256 + ch]), omlb = __expf(misc[MISC_LOG1M + (dir * 4 + layer) * 256 + ch]);
          auto logf_gate = [&](float f) { const float sg = __builtin_amdgcn_rcpf(1.f + __builtin_amdgcn_exp2f(-1.4426950408889634f * f)); return __logf(__builtin_fmaf(omlb, sg, lbv)); };
          float ps = 0.f, gv[32];
#pragma unroll
          for (int t8 = 0; t8 < 32; t8 += 8) {
              float fv[8];
#pragma unroll
              for (int q = 0; q < 8; ++q) fv[q] = G[(size_t)(32 * hf + t8 + q) * 256];
#pragma unroll
              for (int q = 0; q < 8; ++q) { gv[t8 + q] = logf_gate(fv[q]); ps += gv[t8 + q]; }
          }
          __syncthreads(); part[hf * 256 + ch] = ps; __syncthreads();
          const float p0 = part[ch], p1 = part[256 + ch]; const float blast = p0 + p1; const float mref = dir == 0 ? p0 : p1;
          float bc = dir == 0 ? (hf ? p0 : 0.f) : (hf ? 0.f : p1); const float elm = __expf(blast - mref);
          unsigned* QK = (unsigned*)G;
          bf16_t* KDT = (bf16_t*)(p.k->ws + OFF_KDT) + (((size_t)dir * NB + b) * 256 + ch) * KEYS + 64 * slot + 32 * hf;
          const bf16_t* cq = CQ + (size_t)row0 * 256 + ch;
#pragma unroll
          for (int o8 = 0; o8 < 4; ++o8) {
              float kv[8], cqv[8];
#pragma unroll
              for (int q = 0; q < 8; ++q) { const int tl = dir == 0 ? (o8 * 8 + q) : (31 - (o8 * 8 + q)); cqv[q] = bf2f(cq[(size_t)(32 * hf + tl) * 256]); }
#pragma unroll
              for (int q = 0; q < 8; ++q) {
                  const int tl = dir == 0 ? (o8 * 8 + q) : (31 - (o8 * 8 + q)); const int tau = 32 * hf + tl;
                  const float g = dir == 0 ? gv[o8 * 8 + q] : gv[31 - (o8 * 8 + q)]; bc += g;
                  const float qv = cqv[q]; const float k = 1.f - __expf(g);
                  const float e = __expf(bc - mref); const float kdv = k * __builtin_amdgcn_rcpf(e);
                  QK[(size_t)tau * 256] = pack2(qv * e, kdv);
                  kv[dir == 0 ? q : 7 - q] = kdv * elm;
              }
              const int t8 = dir == 0 ? o8 * 8 : 24 - o8 * 8;
              *(u32x4*)(KDT + t8) = __builtin_bit_cast(u32x4, pack8(kv[0], kv[1], kv[2], kv[3], kv[4], kv[5], kv[6], kv[7]));
          }
          if (hf == 0) { float* ev = (float*)(p.k->ws + OFF_EV) + (((size_t)dir * NB + b) * NSLOT + slot) * 3 * 256 + ch; ev[0] = __expf(blast); ev[256] = __expf(mref); ev[512] = __expf(blast - mref); }
      } }
}

DI void phase_post(const Params& p, int layer) {
    const int lane = ltid(p.wvid) & 63, wv = ltid(p.wvid) >> 6;
    const unsigned* O0 = (const unsigned*)(p.k->ws + OFF_G); const unsigned* O1 = O0 + (size_t)TT * 256; bf16_t* Y = (bf16_t*)(p.k->ws + OFF_YG);
    const f32x4 gn = *(const f32x4*)(p.k->hg_norm_gain + layer * 64 + (lane & 15) * 4);
    const int stride = gridDim.x * 8;
    for (int rowa = lbid() * 8 + wv; rowa < TT; rowa += 4 * stride) {
        u32x4 a[4], bq[4]; u32x2 sgv[4];
#pragma unroll
        for (int r4 = 0; r4 < 4; ++r4) { const int row = rowa + r4 * stride; if (row < TT) { a[r4] = *(const u32x4*)(O0 + (size_t)row * 256 + lane * 4); bq[r4] = *(const u32x4*)(O1 + (size_t)row * 256 + lane * 4);
            sgv[r4] = *(const u32x2*)(Y + (size_t)row * 1024 + 512 + lane * 4); } }
#pragma unroll
        for (int r4 = 0; r4 < 4; ++r4) { const int row = rowa + r4 * stride; if (row < TT) {
            f32x4 v; v[0] = bflo(a[r4].x) + bflo(bq[r4].x); v[1] = bflo(a[r4].y) + bflo(bq[r4].y); v[2] = bflo(a[r4].z) + bflo(bq[r4].z); v[3] = bflo(a[r4].w) + bflo(bq[r4].w);
            float ss = v[0] * v[0] + v[1] * v[1] + v[2] * v[2] + v[3] * v[3];
            ss += __shfl_xor(ss, 1); ss += __shfl_xor(ss, 2); ss += __shfl_xor(ss, 4); ss += __shfl_xor(ss, 8);
            const float r = rsqrtf(ss * (1.f / 64.f) + EPS);
            const u32x2 sg = sgv[r4]; u32x2 o;
            o.x = pack2(v[0] * r * gn[0] * bflo(sg.x), v[1] * r * gn[1] * bfhi(sg.x)); o.y = pack2(v[2] * r * gn[2] * bflo(sg.y), v[3] * r * gn[3] * bfhi(sg.y));
            *(u32x2*)(Y + (size_t)row * 1024 + 512 + lane * 4) = o; } }
    }
}

DI void phase_mix(LAS unsigned char* lds, const Params& p, int layer) {
    const int tid = ltid(p.wvid), wv = tid >> 6, lane = tid & 63; const bool need_ctx = layer < DEPTH - 1;
#if defined(SELC)
    const int sel = SELC;
#elif defined(MIXSEL)
    const int sel = p.pad_ ? MIXSEL : 15;
#else
    const int sel = 15;
#endif
    if ((sel & 1) && lbid() < 64) hgrn_item(lds, p, lbid() * 2 + (wv >> 2), wv >> 2, wv & 3, lane);
    if ((sel & 2) && lbid() >= 128) {
        const int u = lbid() - 128; SchedOne S; S.u.pm = u >> 4; S.u.pn = u & 15; S.u.sub = 0; S.u.nt = 64;
        S.u.A = (const char*)(p.k->ws + OFF_DFTL) + (size_t)S.u.pm * 256 * 4096 * 2; S.u.B = (const char*)(p.k->ws + OFF_FBL) + (size_t)S.u.pn * 256 * 4096 * 2;
        EpiFour E; E.Y = (bf16_t*)(p.k->ws + OFF_YG); E.rowbase = S.u.pn * SEQ;
        gemm_phase<true>(lds, p.wvid, 4096, 4096, S, E);
        if (need_ctx && u < 16) { SchedOne S2; S2.u.pm = 0; S2.u.pn = u; S2.u.sub = 0; S2.u.nt = 8;
            S2.u.A = (const char*)(p.k->ws + OFF_DFTC); S2.u.B = (const char*)(p.k->ws + OFF_FBC) + (size_t)u * 256 * 512 * 2;
            EpiFour E2; E2.Y = E.Y; E2.rowbase = TL + u * CTX; gemm_phase<true>(lds, p.wvid, 512, 512, S2, E2); }
    }
    int* ctr = (int*)(p.k->ws + OFF_MISC) + MISC_CTR + layer + p.pad_; LAS int* slot = (LAS int*)(lds + LDS_MISC);
    const int nitems = need_ctx ? 1152 : 1024;
    __syncthreads();
    if (tid == 0) *slot = atomicAdd(ctr, 1);
    __syncthreads();
    for (;;) {
        const int it = *slot;
        __syncthreads();
        if (it >= nitems) break;
        if (tid == 0) *slot = atomicAdd(ctr, 1);
        if (it < 512 && (sel & 4)) { const int b = it >> 5, h = (it >> 3) & 3, qb = it & 7; attn_unit<0>(lds, p, layer, b, h, 0, b * SEQ + qb * 256, 0); }
        if (it >= 512 && it < 1024 && (sel & 8)) { const int j = it - 512; const int b = j >> 5, h = (j >> 3) & 3, R = j & 7; attn_unit<1>(lds, p, layer, b, h, 2, b * SEQ + R * 256, R); }
        if (it >= 1024 && it < 1088 && (sel & 4)) { const int j = it - 1024; const int b = j >> 2, h = j & 3; attn_unit<0>(lds, p, layer, b, h, 1, TL + b * CTX, 0); }
        if (it >= 1088 && (sel & 8)) { const int j = it - 1088; const int b = j >> 2, h = j & 3; attn_unit<1>(lds, p, layer, b, h, 1, TL + b * CTX, 0); }
        __syncthreads();
    }
}

DI void run_phase(LAS unsigned char* lds, const Params& pin, int ph) {
    Params p = pin; asm volatile("" : "+s"(p.k));
#ifdef ONLY
    if (ph == 0) return;
#else
    if (ph == 0) { phase_pro(lds, p); return; }
#endif
#ifdef PROBE_SUB
    const int layer = ph >= 100 ? 0 : (ph - 1) / 7, sub = ph >= 100 ? ph - 100 : (ph - 1) % 7; const bool last = layer == DEPTH - 1;
#else
    const int layer = (ph - 1) / 7, sub = (ph - 1) % 7; const bool last = layer == DEPTH - 1;
#endif
#ifdef ONLY
    if (sub != ONLY) return;
#endif
    switch (sub) {
    case 0: if (layer == 0) phase_weights(lds, p, 0, lbid(), gridDim.x); phase_h(p, layer); break;
    case 1: { SchedG1 S; S.nM = TT / 256; S.nN = 16; S.G = gridDim.x; S.c = lbid(); S.A = (const char*)(p.k->ws + OFF_H); S.B = (const char*)(p.k->ws + wsel(layer) + OFF_WIN);
        EpiG1 E; E.ws = p.k->ws; E.layer = layer; gemm_phase<true>(lds, p.wvid, 1024, 1024, S, E); } break;
    case 2: phase_prep(lds, p, layer); break;
    case 3: phase_mix(lds, p, layer); break;
    case 4: phase_post(p, layer); break;
    case 5: { SchedG2 S; S.nM = last ? TL / 256 : TT / 256; S.G = gridDim.x; S.c = lbid(); S.YG = (const char*)(p.k->ws + OFF_YG); S.WUP = (const char*)(p.k->ws + wsel(layer) + OFF_WUP);
        S.H = (const char*)(p.k->ws + OFF_H); S.WM = (const char*)(p.k->ws + wsel(layer) + OFF_WM);
        EpiG2 E; E.brs = (u32x4*)(p.k->ws + OFF_BRS) + (size_t)lbid() * 512 * 16; E.accs = (u32x4*)(p.k->ws + OFF_ACCS) + (size_t)lbid() * 512 * 16; E.ACC = (bf16_t*)(p.k->ws + OFF_ACC);
        const int su = lbid() & 63, pr = lbid() >> 6; E.t4 = (u32x4*)(p.k->ws + OFF_T4) + ((size_t)(su * 4 + pr) * 16) * 512;
        gemm_phase<true>(lds, p.wvid, 1024, 1024, S, E);
        if (!last) {
            const int tid = ltid(p.wvid); LAS unsigned* sl = (LAS unsigned*)(lds + LDS_MISC + 32);
            __syncthreads();
            if (tid == 0) { __builtin_amdgcn_fence(__ATOMIC_RELEASE, "agent"); asm volatile("s_waitcnt vmcnt(0)" ::: "memory");
                *sl = xb_add((unsigned*)(p.k->ws + OFF_BAR) + XB_SPLITCNT + layer * 64 + su, 1u); }
            __syncthreads();
            if (*sl == 3u) {
                __builtin_amdgcn_fence(__ATOMIC_ACQUIRE, "agent"); asm volatile("s_waitcnt vmcnt(0)" ::: "memory");
                int pm, pn; tile_order(2 * (int)gridDim.x + su, S.nM, 4, pm, pn);
                const int w2 = tid >> 6, fr = tid & 15, fq = (tid >> 4) & 3; const int row0 = pm * 256 + (w2 >> 2) * 64 + fr, col0 = pn * 256 + (w2 & 3) * 32 + 8 * fq;
                const u32x4* T = (const u32x4*)(p.k->ws + OFF_T4) + ((size_t)(su * 4) * 16) * 512 + tid; bf16_t* ACC = (bf16_t*)(p.k->ws + OFF_ACC);
                for (int idx = 0; idx < 16; ++idx) {
                    u32x4 tq[4];
#pragma unroll
                    for (int q = 0; q < 4; ++q) tq[q] = T[((size_t)q * 16 + idx) * 512];
                    float t[8] = {0.f, 0.f, 0.f, 0.f, 0.f, 0.f, 0.f, 0.f};
#pragma unroll
                    for (int q = 0; q < 4; ++q) { t[0] += bflo(tq[q].x); t[1] += bfhi(tq[q].x); t[2] += bflo(tq[q].y); t[3] += bfhi(tq[q].y); t[4] += bflo(tq[q].z); t[5] += bfhi(tq[q].z); t[6] += bflo(tq[q].w); t[7] += bfhi(tq[q].w); }
                    u32x4 o; o.x = pack2(t[0], t[1]); o.y = pack2(t[2], t[3]); o.z = pack2(t[4], t[5]); o.w = pack2(t[6], t[7]);
                    const int ai = idx >> 3, m = (idx >> 1) & 3, bj = idx & 1;
                    *(u32x4*)(ACC + (size_t)(row0 + ai * 128 + m * 16) * 1024 + col0 + bj * 128) = o;
                }
            }
        } }
        break;
    case 7: break;
    case 6: { SchedG3 S; S.nM = last ? TL / 256 : TT / 256; S.G = gridDim.x; S.c = lbid(); S.A = (const char*)(p.k->ws + OFF_ACC); S.B = (const char*)(p.k->ws + wsel(layer) + OFF_WO);
        EpiG3 E; E.p = p; E.layer = layer; gemm_phase<true>(lds, p.wvid, 1024, 1024, S, E);
        if (!last && lbid() >= 64) phase_weights(lds, p, layer + 1, lbid() - 64, 192); }
        break;
    }
}

constexpr int NPHASE = 1 + 7 * DEPTH;

__global__ void __launch_bounds__(512, 2) mega(KArgs ka) {
    Params p; p.k = (KPtr)__builtin_amdgcn_kernarg_segment_ptr(); p.pad_ = 0; p.wvid = __builtin_amdgcn_readfirstlane((int)threadIdx.x >> 6);
    extern __shared__ __attribute__((aligned(16))) unsigned char shm[];
    LAS unsigned char* lds = (LAS unsigned char*)shm;
#if COOP
    cg::grid_group grid = cg::this_grid();
    volatile LAS unsigned* xst = (volatile LAS unsigned*)(lds + LDS_MISC + 16);
    { const int t0 = ltid(p.wvid); if (t0 == 0) { xst[0] = 0u; xst[1] = 0u; } __syncthreads(); }
    const XcdBarrier xb = xcd_barrier_post((unsigned*)(p.k->ws + OFF_BAR), xst, ltid(p.wvid));
#ifdef PROBE_SUB
    constexpr int NPRE = 1 + PROBE_REP;
    for (int s = 0; s < NPRE + NPHASE; ++s) {
        const int ph = s < NPRE ? (s == 0 ? 0 : 100 + PROBE_SUB) : s - NPRE;
        p.pad_ = (s >= 1 && s < NPRE) ? 4 + ((s - 1) & 3) : 0;
        run_phase(lds, p, ph); if (s + 1 < NPRE + NPHASE) { if (s == 0) grid.sync(); else xcd_barrier(xb, ltid(p.wvid)); }
    }
#else
    for (int ph = p.k->phase_lo; ph < p.k->phase_hi; ++ph) { run_phase(lds, p, ph); if (ph + 1 < p.k->phase_hi) { if (ph == 0) grid.sync(); else xcd_barrier(xb, ltid(p.wvid)); } }
#endif
#else
    for (int ph = p.k->phase_lo; ph < p.k->phase_hi; ++ph) run_phase(lds, p, ph);
#endif
}

extern "C" void kernel_launch(void* const* d_in, const int* in_sizes, int n_in, void* d_out, int out_size, void* d_ws, size_t ws_size, hipStream_t stream) {
    if (ws_size < OFF_END) { fprintf(stderr, "workspace too small: %zu < %zu\n", ws_size, (size_t)OFF_END); return; }
    KArgs p{};
    const float** f = (const float**)&p;
    for (int i = 0; i < 18; ++i) f[i] = (const float*)d_in[i];
    p.out = (float*)d_out; p.ws = (unsigned char*)d_ws;
    static bool attr = false;
    if (!attr) { (void)hipFuncSetAttribute((const void*)mega, hipFuncAttributeMaxDynamicSharedMemorySize, LDS_BYTES); attr = true; }
#if COOP
    p.phase_lo = 0; p.phase_hi = NPHASE;
    (void)hipMemsetAsync((unsigned char*)d_ws + OFF_BAR, 0, 16384, stream);
    void* args[] = {&p};
    hipError_t e = hipLaunchCooperativeKernel((const void*)mega, dim3(256), dim3(512), args, LDS_BYTES, stream);
    if (e != hipSuccess) fprintf(stderr, "cooperative launch failed: %s\n", hipGetErrorString(e));
#else
    for (int ph = 0; ph < NPHASE; ++ph) { p.phase_lo = ph; p.phase_hi = ph + 1; hipLaunchKernelGGL(mega, dim3(256), dim3(512), LDS_BYTES, stream, p); }
#endif
}
```

```cpp
#include <hip/hip_runtime.h>
#include <hip/hip_cooperative_groups.h>
#include <cstdio>
namespace cg = cooperative_groups;

#ifndef COOP
#define COOP 1
#endif

#define LAS __attribute__((address_space(3)))
#define DI __device__ __forceinline__
typedef unsigned short bf16_t;
typedef short bf16x8 __attribute__((ext_vector_type(8)));
typedef float f32x4 __attribute__((ext_vector_type(4)));
typedef float f32x16 __attribute__((ext_vector_type(16)));
typedef unsigned u32x4 __attribute__((ext_vector_type(4)));
typedef unsigned u32x2 __attribute__((ext_vector_type(2)));

constexpr int DM = 1024, NB = 16, SEQ = 2048, DEPTH = 4, CTX = 256;
constexpr int TL = NB * SEQ, TC = NB * CTX, TT = TL + TC;
constexpr int KEYS = SEQ + CTX;
constexpr int NSLOT = KEYS / 64;
constexpr float EPS = 1e-6f;
constexpr float LOG2E = 1.4426950408889634f;

constexpr size_t SZ_XC = (size_t)TC * DM * 4;
constexpr size_t SZ_MOD = 1u << 20;
constexpr size_t SZ_MISC = 1u << 16;
constexpr size_t SZ_WIN = (size_t)4096 * 1024 * 2, SZ_WUP = (size_t)1024 * 1024 * 2, SZ_WM = (size_t)4096 * 1024 * 2, SZ_WO = (size_t)1024 * 1024 * 2;
constexpr size_t SZ_DFTL = (size_t)2048 * 4096 * 2, SZ_DFTC = (size_t)256 * 512 * 2;
constexpr size_t SZ_TOK256 = (size_t)TT * 256 * 2;
constexpr size_t SZ_TOK1024 = (size_t)TT * 1024 * 2;
constexpr size_t SZ_VT = (size_t)NB * 256 * KEYS * 2;
constexpr size_t SZ_EV = (size_t)2 * NB * NSLOT * 3 * 256 * 4;
constexpr size_t SZ_FBL = (size_t)4096 * 4096 * 2, SZ_FBC = (size_t)4096 * 512 * 2;
constexpr size_t SZ_G = (size_t)2 * TT * 256 * 4;
constexpr size_t SZ_SCR = (size_t)256 * 512 * 128 * 4;

constexpr size_t OFF_XC = 0;
constexpr size_t OFF_MOD = OFF_XC + SZ_XC;
constexpr size_t OFF_MISC = OFF_MOD + SZ_MOD;
constexpr size_t OFF_WIN = OFF_MISC + SZ_MISC;
constexpr size_t OFF_WUP = OFF_WIN + SZ_WIN;
constexpr size_t OFF_WM = OFF_WUP + SZ_WUP;
constexpr size_t OFF_WO = OFF_WM + SZ_WM;
constexpr size_t OFF_DFTL = OFF_WO + SZ_WO;
constexpr size_t OFF_DFTC = OFF_DFTL + SZ_DFTL;
constexpr size_t OFF_HG = OFF_DFTC + SZ_DFTC;
constexpr size_t OFF_QD = OFF_HG, OFF_KD = OFF_QD + 2 * SZ_TOK256, OFF_KDT = OFF_KD + 2 * SZ_TOK256;
constexpr size_t OFF_H = OFF_HG;
constexpr size_t OFF_EV = OFF_KDT + 2 * SZ_VT;
constexpr size_t OFF_ZQK = OFF_EV + SZ_EV;
constexpr size_t OFF_ACC = OFF_ZQK;
constexpr size_t OFF_YG = OFF_ZQK + SZ_TOK1024;
constexpr size_t OFF_VT = OFF_YG + SZ_TOK1024;
constexpr size_t OFF_FBL = OFF_VT + 3 * SZ_VT;
constexpr size_t OFF_FBC = OFF_FBL + SZ_FBL;
constexpr size_t OFF_G = OFF_FBC + SZ_FBC;
constexpr size_t OFF_O32 = OFF_G;
constexpr size_t OFF_CQ = OFF_G + SZ_G;
constexpr size_t OFF_ROPE = OFF_CQ + SZ_TOK256;
constexpr size_t OFF_BAR = OFF_ROPE + (size_t)2048 * 32 * 4;
constexpr size_t OFF_W2 = OFF_BAR + 16384;
constexpr size_t SZ_W = SZ_WIN + SZ_WUP + SZ_WM + SZ_WO;
constexpr size_t OFF_END = OFF_W2 + SZ_W;
static_assert(OFF_WUP == OFF_WIN + SZ_WIN && OFF_WM == OFF_WUP + SZ_WUP && OFF_WO == OFF_WM + SZ_WM, "weight set must be contiguous");
static_assert(OFF_END <= (size_t)536870912, "workspace budget");
constexpr size_t OFF_BRS = OFF_VT, OFF_ACCS = OFF_BRS + SZ_SCR;
constexpr size_t OFF_T4 = OFF_BRS + 33554432;
static_assert(OFF_T4 + 33554432 <= OFF_ACCS, "T4 overlaps the partial-sum stash");
constexpr int XB_SPLITCNT = 3584;
static_assert(OFF_ACCS + SZ_SCR <= OFF_ROPE, "scratch alias overflow");
static_assert(SZ_TOK1024 == 4 * SZ_TOK256, "H alias");

constexpr int MISC_LOGLB = 0;
constexpr int MISC_LOG1M = 2048;
constexpr int MISC_LAM = 4096;
constexpr int MISC_CTR = 4160;

constexpr int LDS_BYTES = 131072 + 4096;
constexpr int LDS_MISC = 131072;

struct KArgs {
    const float *x, *c, *ctx, *c_ctx, *norm_gain, *w_mod, *b_mod, *w_in, *da_qk_gain, *da_lambda, *da_subln_gain, *na_qk_gain, *na_rpb, *hg_lb_logits, *hg_norm_gain, *w_up, *w_merge, *w_out;
    float* out;
    unsigned char* ws;
    int phase_lo, phase_hi;
};
typedef const KArgs __attribute__((address_space(4)))* KPtr;
struct Params { KPtr k; int wvid, pad_; };

DI int ltid(int wvid) { int t; asm volatile("v_mbcnt_lo_u32_b32 %0, -1, 0\n\tv_mbcnt_hi_u32_b32 %0, -1, %0" : "=v"(t)); return wvid * 64 + t; }
DI int lbid() { int b = (int)blockIdx.x; asm volatile("" : "+s"(b)); return b; }
typedef float f32x2v __attribute__((ext_vector_type(2)));
typedef __bf16 bf16x2v __attribute__((ext_vector_type(2)));
DI unsigned short f2bf(float f) { __bf16 b = (__bf16)f; return __builtin_bit_cast(unsigned short, b); }
DI float bf2f(unsigned short b) { return __uint_as_float(((unsigned)b) << 16); }
DI unsigned pack2(float lo, float hi) { f32x2v v = {lo, hi}; bf16x2v r = __builtin_convertvector(v, bf16x2v); return __builtin_bit_cast(unsigned, r); }
DI float bflo(unsigned u) { return __uint_as_float(u << 16); }
DI float bfhi(unsigned u) { return __uint_as_float(u & 0xffff0000u); }
DI u32x2 mku2(unsigned a, unsigned b) { u32x2 r; r.x = a; r.y = b; return r; }
DI bf16x8 mk8(u32x2 a, u32x2 b) { u32x4 u; u.x = a.x; u.y = a.y; u.z = b.x; u.w = b.y; return __builtin_bit_cast(bf16x8, u); }
DI bf16x8 mk8u(u32x4 u) { return __builtin_bit_cast(bf16x8, u); }
DI bf16x8 pack8(float a, float b, float c, float d, float e, float f, float g, float h) { u32x4 u; u.x = pack2(a, b); u.y = pack2(c, d); u.z = pack2(e, f); u.w = pack2(g, h); return __builtin_bit_cast(bf16x8, u); }
DI float siluf(float v) { return v * __builtin_amdgcn_rcpf(1.f + __builtin_amdgcn_exp2f(-1.4426950408889634f * v)); }
DI float sigmoidf_(float v) { return __builtin_amdgcn_rcpf(1.f + __builtin_amdgcn_exp2f(-1.4426950408889634f * v)); }
DI int crow(int i, int h) { return (i & 3) + 8 * (i >> 2) + 4 * h; }
#define MFMA32(a, b, c) __builtin_amdgcn_mfma_f32_32x32x16_bf16((a), (b), (c), 0, 0, 0)
DI f32x16 zero16() { f32x16 z; for (int i = 0; i < 16; ++i) z[i] = 0.f; return z; }
DI const float* xrow_in(const Params& p, int layer, int row) {
    if (layer == 0) return row < TL ? p.k->x + (size_t)row * DM : p.k->ctx + (size_t)(row - TL) * DM;
    return row < TL ? p.k->out + (size_t)row * DM : (const float*)(p.k->ws + OFF_XC) + (size_t)(row - TL) * DM; }
DI size_t wsel(int layer) { return (layer & 1) ? (OFF_W2 - OFF_WIN) : 0; }
DI float* xrow(const Params& p, int row) { return row < TL ? p.k->out + (size_t)row * DM : (float*)(p.k->ws + OFF_XC) + (size_t)(row - TL) * DM; }

#define XB_TMO      128
#define XB_XCNT(j)  (256  + 64 * (j))
#define XB_XSUB(j)  (1280 + 64 * (j))
#define XB_XGEN(j)  (2304 + 64 * (j))
#define XB_TOP      3328
#define XB_TOPGEN   3392
#define XCD_BAR_WORDS 3456
#define XB_SPIN_CAP (1u << 18)
DI unsigned xb_ld(unsigned* p) { return __hip_atomic_load(p, __ATOMIC_RELAXED, __HIP_MEMORY_SCOPE_AGENT); }
DI unsigned xb_add(unsigned* p, unsigned v) { return __hip_atomic_fetch_add(p, v, __ATOMIC_RELAXED, __HIP_MEMORY_SCOPE_AGENT); }
DI unsigned xb_xcc_id() { return (unsigned)__builtin_amdgcn_s_getreg((3 << 11) | 20) & 0xFu; }
#define XB_SPIN(cond, bar) do { unsigned _sp = 0; while (cond) { __builtin_amdgcn_s_sleep(1); \
    if ((++_sp & 255u) == 0u) { if (xb_ld(&(bar)[XB_TMO])) break; if (_sp > XB_SPIN_CAP) { atomicAdd(&(bar)[XB_TMO], 1u); break; } } } } while (0)
struct XcdBarrier { unsigned* bar; unsigned x; volatile LAS unsigned* st; };
DI XcdBarrier xcd_barrier_post(unsigned* bar, volatile LAS unsigned* st, int tid) {
    XcdBarrier b; b.bar = bar; b.x = xb_xcc_id(); b.st = st;
    if (tid == 0) (void)xb_add(&bar[XB_XCNT(b.x)], 1u);
    return b;
}
DI void xcd_barrier_complete(unsigned* bar, unsigned x, unsigned& nloc, unsigned& nx) {
    const unsigned G = gridDim.x;
    unsigned sum, cnt, mine, sp = 0u;
    for (;;) {
        sum = 0u; cnt = 0u; mine = 0u;
#pragma unroll
        for (unsigned j = 0; j < 16; ++j) { const unsigned c = xb_ld(&bar[XB_XCNT(j)]); sum += c; cnt += (c > 0u) ? 1u : 0u; mine = (j == x) ? c : mine; }
        if (sum == G) break;
        __builtin_amdgcn_s_sleep(1);
        if ((++sp & 255u) == 0u) { if (xb_ld(&bar[XB_TMO])) break; if (sp > XB_SPIN_CAP) { atomicAdd(&bar[XB_TMO], 1u); break; } }
    }
    nloc = mine > 0u ? mine : 1u; nx = cnt > 0u ? cnt : 1u;
}
DI void xcd_barrier(const XcdBarrier& b, int tid) {
    asm volatile("s_waitcnt vmcnt(0)" ::: "memory");
    __syncthreads();
    if (tid == 0) {
        unsigned* bar = b.bar;
        __builtin_amdgcn_s_waitcnt(0);
        unsigned nloc = b.st[0], nx = b.st[1];
        if (nloc == 0u) { xcd_barrier_complete(bar, b.x, nloc, nx); b.st[0] = nloc; b.st[1] = nx; }
        const unsigned old = xb_add(&bar[XB_XSUB(b.x)], 1u);
        const unsigned gen = old / nloc;
        if (old + 1u == (gen + 1u) * nloc) {
            __builtin_amdgcn_fence(__ATOMIC_RELEASE, "agent");
            asm volatile("s_waitcnt vmcnt(0)" ::: "memory");
            const unsigned og = xb_add(&bar[XB_TOP], 1u);
            const unsigned tg = og / nx;
            if (og + 1u == (tg + 1u) * nx) xb_add(&bar[XB_TOPGEN], 1u);
            else XB_SPIN(xb_ld(&bar[XB_TOPGEN]) == tg, bar);
            __builtin_amdgcn_fence(__ATOMIC_ACQUIRE, "agent");
            xb_add(&bar[XB_XGEN(b.x)], 1u);
            asm volatile("s_waitcnt vmcnt(0)" ::: "memory");
        } else {
            XB_SPIN(xb_ld(&bar[XB_XGEN(b.x)]) == gen, bar);
            __builtin_amdgcn_fence(__ATOMIC_ACQUIRE, "agent");
            asm volatile("s_waitcnt vmcnt(0)" ::: "memory");
        }
    }
    __syncthreads();
}

constexpr int BM = 256, BK = 64, HALF = 128, HTB = HALF * BK * 2, NXCD = 8, WGM = 8;
DI int lds_byte(int r, int c) { const int st = (r >> 4) * 2 + (c >> 5), rr = r & 15, cc = c & 31, ob = rr * 64 + cc * 2; return st * 1024 + (ob ^ (((ob >> 9) & 1) << 5)); }
DI void stage_rc(int b, int& R, int& C) { const int st = b / 1024, sb = b % 1024, swz = sb ^ (((sb >> 9) & 1) << 5); R = (st >> 1) * 16 + swz / 64; C = (st & 1) * 32 + (swz % 64) / 2; }
DI int perm32(int rho) { const int n = rho >> 4, i = rho & 15; return 8 * (i >> 2) + 4 * n + (i & 3); }

struct GUnit { const char* A; const char* B; int nt, pm, pn, sub; };

DI void tile_order(int L, int nM, int nN, int& pm, int& pn) {
    const int nwg = nM * nN; int wgid = L;
    { const int q = nwg / NXCD, r = nwg % NXCD, xcd = wgid % NXCD, off = wgid / NXCD; wgid = (xcd < r ? xcd * (q + 1) : r * (q + 1) + (xcd - r) * q) + off; }
    const int nig = WGM * nN, gid = wgid / nig, fm = gid * WGM, gsz = (nM - fm) < WGM ? (nM - fm) : WGM;
    pm = fm + ((wgid % nig) % gsz); pn = (wgid % nig) / gsz;
}

template <bool PERM, class Sched, class Epi>
DI void gemm_phase(LAS unsigned char* lds, const int wvid, const int lda, const int ldb, const Sched& S, const Epi& E) {
    const int tid = ltid(wvid), wid = __builtin_amdgcn_readfirstlane(tid >> 6), lane = tid & 63, wr = wid >> 2, wc = wid & 3, fr = lane & 15, fq = lane >> 4;
    unsigned voffA[2], voffB[2];
#pragma unroll
    for (int i = 0; i < 2; ++i) { int R, C; stage_rc(tid * 16 + i * 8192, R, C); const int Rb = PERM ? ((R & ~31) + perm32(R & 31)) : R;
        voffA[i] = (unsigned)(R * lda + C) * 2u; voffB[i] = (unsigned)(Rb * ldb + C) * 2u; }
    const size_t kstep = (size_t)(BK * 2);
    const size_t hstepA = (size_t)HALF * lda * 2, hstepB = (size_t)HALF * ldb * 2;
    const unsigned ldsw = (unsigned)wid * 1024u;
    const int aoff = lds_byte(wr * 64 + fr, fq * 8), boff = lds_byte(wc * 32 + fr, fq * 8);
#define PG8_SA(b, h) (((b) * 2 + (h)) * HTB)
#define PG8_SB(b, h) ((4 + (b) * 2 + (h)) * HTB)
#define PG8_STAGE(bufoff, gbase, voff) do { _Pragma("unroll") for (int _i = 0; _i < 2; ++_i) \
        __builtin_amdgcn_global_load_lds((const unsigned*)((const char*)(gbase) + (voff)[_i]), (LAS unsigned*)(lds + (bufoff) + ldsw + _i * 8192), 16, 0, 0); } while (0)
#define PG8_LDA(dst, b, h) do { _Pragma("unroll") for (int m = 0; m < 4; ++m) _Pragma("unroll") for (int k = 0; k < 2; ++k) dst[m][k] = *(const LAS bf16x8*)(lds + PG8_SA(b, h) + aoff + m * 2048 + k * 1024); } while (0)
#define PG8_LDB(dst, b, h) do { _Pragma("unroll") for (int n = 0; n < 2; ++n) _Pragma("unroll") for (int k = 0; k < 2; ++k) dst[n][k] = *(const LAS bf16x8*)(lds + PG8_SB(b, h) + boff + n * 2048 + k * 1024); } while (0)
#define PG8_MMA(ai, bj, At, Bt) do { __builtin_amdgcn_s_setprio(1); _Pragma("unroll") for (int m = 0; m < 4; ++m) _Pragma("unroll") for (int n = 0; n < 2; ++n) _Pragma("unroll") for (int k = 0; k < 2; ++k) \
        acc[ai][bj][m][n] = __builtin_amdgcn_mfma_f32_16x16x32_bf16(Bt[n][k], At[m][k], acc[ai][bj][m][n], 0, 0, 0); __builtin_amdgcn_s_setprio(0); } while (0)
#define PG8_WAIT_V(n) asm volatile("s_waitcnt vmcnt(" #n ")" ::: "memory")
#define PG8_WAIT_L(n) asm volatile("s_waitcnt lgkmcnt(" #n ")" ::: "memory")
#define PG8_BAR __builtin_amdgcn_s_barrier()
#define PG8_SCHED __builtin_amdgcn_sched_barrier(0)
    GUnit cur, nxt; int ui = 0;
    if (!S.next(0, cur)) return;
    f32x4 acc[2][2][4][2];
#pragma unroll
    for (int a = 0; a < 2; ++a)
#pragma unroll
        for (int b = 0; b < 2; ++b)
#pragma unroll
            for (int m = 0; m < 4; ++m)
#pragma unroll
                for (int n = 0; n < 2; ++n) acc[a][b][m][n] = (f32x4){0.f, 0.f, 0.f, 0.f};
    bf16x8 At[4][2], B0[2][2], B1[2][2];
    const char* cA = cur.A; const char* cB = cur.B;
    asm volatile("" : "+s"(cA), "+s"(cB));
    PG8_STAGE(PG8_SB(0, 0), cB, voffB); PG8_STAGE(PG8_SA(0, 0), cA, voffA); PG8_STAGE(PG8_SB(0, 1), cB + hstepB, voffB); PG8_STAGE(PG8_SA(0, 1), cA + hstepA, voffA);
    if (wr == 1) PG8_BAR;
    PG8_WAIT_V(4); PG8_BAR;
    PG8_STAGE(PG8_SB(1, 0), cB + kstep, voffB); PG8_STAGE(PG8_SA(1, 0), cA + kstep, voffA); PG8_STAGE(PG8_SB(1, 1), cB + hstepB + kstep, voffB);
    PG8_WAIT_V(6); PG8_BAR;
    for (;;) {
        const bool has_next = S.next(ui + 1, nxt);
        const char* nA = has_next ? nxt.A : cA; const char* nB = has_next ? nxt.B : cB;
        asm volatile("" : "+s"(nA), "+s"(nB));
        const int nt = cur.nt;
        for (int t = 0; t < nt; t += 2) {
            const bool last = (t == nt - 2);
            const char* a1 = cA + (size_t)(t + 1) * kstep;
            const char* a2 = last ? nA : cA + (size_t)(t + 2) * kstep; const char* b2 = last ? nB : cB + (size_t)(t + 2) * kstep;
            const char* a3 = a2 + kstep; const char* b3 = b2 + kstep;
            PG8_LDB(B0, 0, 0); PG8_SCHED; PG8_LDA(At, 0, 0); PG8_STAGE(PG8_SA(1, 1), a1 + hstepA, voffA);
            PG8_WAIT_L(8); PG8_BAR; PG8_WAIT_L(0); PG8_MMA(0, 0, At, B0); PG8_BAR; PG8_SCHED;
            PG8_LDB(B1, 0, 1); PG8_STAGE(PG8_SB(0, 0), b2, voffB);
            PG8_BAR; PG8_WAIT_L(0); PG8_MMA(0, 1, At, B1); PG8_BAR;
            PG8_LDA(At, 0, 1); PG8_STAGE(PG8_SA(0, 0), a2, voffA);
            PG8_BAR; PG8_WAIT_L(0); PG8_MMA(1, 0, At, B0); PG8_BAR; PG8_SCHED;
            PG8_STAGE(PG8_SB(0, 1), b2 + hstepB, voffB);
            PG8_WAIT_V(6); PG8_BAR; PG8_MMA(1, 1, At, B1); PG8_BAR;
            PG8_LDB(B0, 1, 0); PG8_SCHED; PG8_LDA(At, 1, 0); PG8_STAGE(PG8_SA(0, 1), a2 + hstepA, voffA);
            PG8_WAIT_L(8); PG8_BAR; PG8_WAIT_L(0); PG8_MMA(0, 0, At, B0); PG8_BAR; PG8_SCHED;
            PG8_LDB(B1, 1, 1); PG8_STAGE(PG8_SB(1, 0), b3, voffB);
            PG8_BAR; PG8_WAIT_L(0); PG8_MMA(0, 1, At, B1); PG8_BAR;
            PG8_LDA(At, 1, 1); PG8_STAGE(PG8_SA(1, 0), a3, voffA);
            PG8_BAR; PG8_WAIT_L(0); PG8_MMA(1, 0, At, B0); PG8_BAR; PG8_SCHED;
            PG8_STAGE(PG8_SB(1, 1), b3 + hstepB, voffB);
            PG8_WAIT_V(6); PG8_BAR; PG8_MMA(1, 1, At, B1); PG8_BAR;
        }
        { const int t2 = ltid(wvid); const int w2 = __builtin_amdgcn_readfirstlane(t2 >> 6);
          E(acc, cur, w2 >> 2, w2 & 3, t2 & 15, (t2 >> 4) & 3); }
        if (!has_next) break;
#pragma unroll
        for (int a = 0; a < 2; ++a)
#pragma unroll
            for (int b = 0; b < 2; ++b)
#pragma unroll
                for (int m = 0; m < 4; ++m)
#pragma unroll
                    for (int n = 0; n < 2; ++n) acc[a][b][m][n] = (f32x4){0.f, 0.f, 0.f, 0.f};
        cur = nxt; cA = nA; cB = nB; ++ui;
    }
    PG8_WAIT_V(0);
    if (wr == 0) PG8_BAR;
    PG8_BAR;
#undef PG8_SA
#undef PG8_SB
#undef PG8_STAGE
#undef PG8_LDA
#undef PG8_LDB
#undef PG8_MMA
#undef PG8_WAIT_V
#undef PG8_WAIT_L
#undef PG8_BAR
#undef PG8_SCHED
}

#define EPI8_BEGIN _Pragma("unroll") for (int ai = 0; ai < 2; ++ai) _Pragma("unroll") for (int m = 0; m < 4; ++m) _Pragma("unroll") for (int bj = 0; bj < 2; ++bj) { \
    const int dr = ai * 128 + m * 16, dc = bj * 128, idx = (ai * 4 + m) * 2 + bj; const f32x4 v0 = acc[ai][bj][m][0], v1 = acc[ai][bj][m][1]; (void)dr; (void)dc; (void)idx;
#define EPI8_END asm volatile("" ::: "memory"); }

struct SchedG1 {
    int nM, nN, G, c; const char* A; const char* B;
    DI bool next(int i, GUnit& u) const {
        const int L = i * G + c; if (L >= nM * nN) return false;
        tile_order(L, nM, nN, u.pm, u.pn); u.sub = 0; u.nt = 16;
        u.A = A + (size_t)u.pm * 256 * 1024 * 2; u.B = B + (size_t)u.pn * 256 * 1024 * 2; return true;
    }
};
struct EpiG1 {
    unsigned char* ws; int layer;
    DI void operator()(const f32x4 (&acc)[2][2][4][2], const GUnit& u, int wr, int wc, int fr, int fq) const {
        const int rl0 = wr * 64 + fr, col0 = wc * 32 + 8 * fq, pm = u.pm, pn = u.pn;
        const bool lat = pm < 128; const int b = lat ? (pm >> 3) : (pm - 128);
        const int row0 = pm * 256 + rl0;
        if (pn == 7 || pn == 8) {
            float* Gp = (float*)(ws + OFF_G) + (size_t)(pn - 7) * TT * 256 + (size_t)row0 * 256 + col0;
            EPI8_BEGIN { float* d = Gp + (size_t)dr * 256 + dc; *(f32x4*)d = v0; *(f32x4*)(d + 4) = v1; } EPI8_END
        } else if (pn == 2 || pn == 5 || pn == 9 || pn == 10 || pn == 11) {
            bf16_t* base; int ldt, pos;
            if (pn >= 10) { const int part = pn - 10;
                if (lat) { base = (bf16_t*)(ws + OFF_FBL); ldt = 4096; pos = part * 2048 + (pm & 7) * 256 + rl0; }
                else { base = (bf16_t*)(ws + OFF_FBC); ldt = 512; pos = part * 256 + rl0; } }
            else { base = (bf16_t*)(ws + OFF_VT + (size_t)(pn == 2 ? 0 : pn == 5 ? 1 : 2) * SZ_VT); ldt = KEYS; pos = (lat ? (pm & 7) * 256 : SEQ) + rl0; }
            bf16_t* d0 = base + ((size_t)b * 256 + col0) * ldt + pos;
            EPI8_BEGIN { bf16_t* d = d0 + (size_t)dc * ldt + dr;
#pragma unroll
                for (int j = 0; j < 4; ++j) { d[(size_t)j * ldt] = f2bf(v0[j]); d[(size_t)(4 + j) * ldt] = f2bf(v1[j]); } } EPI8_END
        } else {
            bf16_t* d0; int ldn; bool act;
            if (pn == 6) { d0 = (bf16_t*)(ws + OFF_CQ) + col0; ldn = 256; act = true; }
            else if (pn >= 12) { d0 = (bf16_t*)(ws + OFF_YG) + (pn - 12) * 256 + col0; ldn = 1024; act = true; }
            else { d0 = (bf16_t*)(ws + OFF_ZQK) + (pn == 0 ? 0 : pn == 1 ? 256 : pn == 3 ? 512 : 768) + col0; ldn = 1024; act = false; }
            d0 += (size_t)row0 * ldn;
            if (act) { EPI8_BEGIN { u32x4 o; o.x = pack2(siluf(v0[0]), siluf(v0[1])); o.y = pack2(siluf(v0[2]), siluf(v0[3])); o.z = pack2(siluf(v1[0]), siluf(v1[1])); o.w = pack2(siluf(v1[2]), siluf(v1[3]));
                *(u32x4*)(d0 + (size_t)dr * ldn + dc) = o; } EPI8_END }
            else { EPI8_BEGIN { u32x4 o; o.x = pack2(v0[0], v0[1]); o.y = pack2(v0[2], v0[3]); o.z = pack2(v1[0], v1[1]); o.w = pack2(v1[2], v1[3]);
                *(u32x4*)(d0 + (size_t)dr * ldn + dc) = o; } EPI8_END }
        }
    }
};

struct SchedOne { GUnit u; DI bool next(int i, GUnit& o) const { if (i != 0) return false; o = u; return true; } };
struct EpiFour {
    bf16_t* Y; int rowbase;
    DI void operator()(const f32x4 (&acc)[2][2][4][2], const GUnit& u, int wr, int wc, int fr, int fq) const {
        const int r0 = rowbase + u.pm * 256 + wr * 64 + fr, c0 = 768 + wc * 32 + 8 * fq;
#pragma unroll
        for (int g8 = 0; g8 < 2; ++g8) {
            u32x4 gq[8];
#pragma unroll
            for (int q = 0; q < 8; ++q) { const int idx = g8 * 8 + q, ai = idx >> 3, m = (idx >> 1) & 3, bj = idx & 1; gq[q] = *(const u32x4*)(Y + (size_t)(r0 + ai * 128 + m * 16) * 1024 + c0 + bj * 128); }
#pragma unroll
            for (int q = 0; q < 8; ++q) { const int idx = g8 * 8 + q, ai = idx >> 3, m = (idx >> 1) & 3, bj = idx & 1; const f32x4 v0 = acc[ai][bj][m][0], v1 = acc[ai][bj][m][1]; const u32x4 g = gq[q]; u32x4 o;
                o.x = pack2(v0[0] * bflo(g.x), v0[1] * bfhi(g.x)); o.y = pack2(v0[2] * bflo(g.y), v0[3] * bfhi(g.y));
                o.z = pack2(v1[0] * bflo(g.z), v1[1] * bfhi(g.z)); o.w = pack2(v1[2] * bflo(g.w), v1[3] * bfhi(g.w));
                *(u32x4*)(Y + (size_t)(r0 + ai * 128 + m * 16) * 1024 + c0 + bj * 128) = o; }
            asm volatile("" ::: "memory");
        }
    }
};

struct SchedG2 {
    int nM, G, c; const char *YG, *WUP, *H, *WM;
    DI bool next(int i, GUnit& u) const {
        const int sup = i >> 3, sub = i & 7;
        if (sup < 2) {
            const int L = sup * G + c; if (L >= nM * 4) return false;
            tile_order(L, nM, 4, u.pm, u.pn); u.sub = sub; const int br = sub >> 1;
            if (!(sub & 1)) { u.nt = 4; u.A = YG + ((size_t)u.pm * 256 * 1024 + br * 256) * 2; u.B = WUP + ((size_t)u.pn * 256 * 1024 + br * 256) * 2; }
            else { u.nt = 16; u.A = H + (size_t)u.pm * 256 * 1024 * 2; u.B = WM + ((size_t)(br * 1024 + u.pn * 256) * 1024) * 2; }
            return true;
        }
        if (sup > 2 || sub > 1 || nM * 4 <= 2 * G) return false;
        const int L = 2 * G + (c & 63), br = c >> 6; tile_order(L, nM, 4, u.pm, u.pn); u.sub = 8 + sub;
        if (!sub) { u.nt = 4; u.A = YG + ((size_t)u.pm * 256 * 1024 + br * 256) * 2; u.B = WUP + ((size_t)u.pn * 256 * 1024 + br * 256) * 2; }
        else { u.nt = 16; u.A = H + (size_t)u.pm * 256 * 1024 * 2; u.B = WM + ((size_t)(br * 1024 + u.pn * 256) * 1024) * 2; }
        return true;
    }
};
struct EpiG2 {
    u32x4* brs; u32x4* accs; bf16_t* ACC; u32x4* t4;
    DI void operator()(const f32x4 (&acc)[2][2][4][2], const GUnit& u, int wr, int wc, int fr, int fq) const {
        const int tid = (wr * 4 + wc) * 64 + fq * 16 + fr; const int sub = u.sub;
        u32x4* B = brs + tid; u32x4* A = accs + tid;
        if (sub == 9) {
            u32x4* T = t4 + tid;
#pragma unroll
            for (int g8 = 0; g8 < 2; ++g8) {
                u32x4 bq[8];
#pragma unroll
                for (int q = 0; q < 8; ++q) bq[q] = B[(size_t)(g8 * 8 + q) * 512];
#pragma unroll
                for (int q = 0; q < 8; ++q) { const int idx = g8 * 8 + q, ai = idx >> 3, m = (idx >> 1) & 3, bj = idx & 1; const f32x4 v0 = acc[ai][bj][m][0], v1 = acc[ai][bj][m][1]; const u32x4 b = bq[q]; u32x4 o;
                    o.x = pack2(sigmoidf_(v0[0]) * bflo(b.x), sigmoidf_(v0[1]) * bfhi(b.x)); o.y = pack2(sigmoidf_(v0[2]) * bflo(b.y), sigmoidf_(v0[3]) * bfhi(b.y));
                    o.z = pack2(sigmoidf_(v1[0]) * bflo(b.z), sigmoidf_(v1[1]) * bfhi(b.z)); o.w = pack2(sigmoidf_(v1[2]) * bflo(b.w), sigmoidf_(v1[3]) * bfhi(b.w));
                    T[(size_t)idx * 512] = o; }
                asm volatile("" ::: "memory");
            }
        } else if (!(sub & 1)) {
            EPI8_BEGIN { u32x4 o; o.x = pack2(v0[0], v0[1]); o.y = pack2(v0[2], v0[3]); o.z = pack2(v1[0], v1[1]); o.w = pack2(v1[2], v1[3]); B[(size_t)idx * 512] = o; } EPI8_END
        } else {
            const int br = sub >> 1; const int row0 = u.pm * 256 + wr * 64 + fr, col0 = u.pn * 256 + wc * 32 + 8 * fq;
#pragma unroll
            for (int g8 = 0; g8 < 2; ++g8) {
                u32x4 bq[8], aq[8];
#pragma unroll
                for (int q = 0; q < 8; ++q) { bq[q] = B[(size_t)(g8 * 8 + q) * 512]; aq[q] = (u32x4){0u, 0u, 0u, 0u}; }
                if (br > 0) {
#pragma unroll
                    for (int q = 0; q < 8; ++q) aq[q] = A[(size_t)(g8 * 8 + q) * 512];
                }
#pragma unroll
                for (int q = 0; q < 8; ++q) {
                    const int idx = g8 * 8 + q, ai = idx >> 3, m = (idx >> 1) & 3, bj = idx & 1, dr = ai * 128 + m * 16, dc = bj * 128;
                    const f32x4 v0 = acc[ai][bj][m][0], v1 = acc[ai][bj][m][1]; const u32x4 b = bq[q], a = aq[q]; float t[8];
                    t[0] = sigmoidf_(v0[0]) * bflo(b.x) + bflo(a.x); t[1] = sigmoidf_(v0[1]) * bfhi(b.x) + bfhi(a.x); t[2] = sigmoidf_(v0[2]) * bflo(b.y) + bflo(a.y); t[3] = sigmoidf_(v0[3]) * bfhi(b.y) + bfhi(a.y);
                    t[4] = sigmoidf_(v1[0]) * bflo(b.z) + bflo(a.z); t[5] = sigmoidf_(v1[1]) * bfhi(b.z) + bfhi(a.z); t[6] = sigmoidf_(v1[2]) * bflo(b.w) + bflo(a.w); t[7] = sigmoidf_(v1[3]) * bfhi(b.w) + bfhi(a.w);
                    u32x4 o; o.x = pack2(t[0], t[1]); o.y = pack2(t[2], t[3]); o.z = pack2(t[4], t[5]); o.w = pack2(t[6], t[7]);
                    if (br < 3) A[(size_t)idx * 512] = o; else *(u32x4*)(ACC + (size_t)(row0 + dr) * 1024 + col0 + dc) = o;
                }
                asm volatile("" ::: "memory");
            }
        }
    }
};

struct SchedG3 {
    int nM, G, c; const char* A; const char* B;
    DI bool next(int i, GUnit& u) const {
        const int L = i * G + c; if (L >= nM * 4) return false;
        tile_order(L, nM, 4, u.pm, u.pn); u.sub = 0; u.nt = 16;
        u.A = A + (size_t)u.pm * 256 * 1024 * 2; u.B = B + (size_t)u.pn * 256 * 1024 * 2; return true;
    }
};
struct EpiG3 {
    Params p; int layer;
    DI void operator()(const f32x4 (&acc)[2][2][4][2], const GUnit& u, int wr, int wc, int fr, int fq) const {
        const int pm = u.pm; const int bi = pm < 128 ? (pm >> 3) : 16;
        const float* gate = (const float*)(p.k->ws + OFF_MOD) + ((size_t)layer * 17 + bi) * 3072 + 2048;
        const int row0 = pm * 256 + wr * 64 + fr, col0 = u.pn * 256 + wc * 32 + 8 * fq;
#pragma unroll
        for (int bj = 0; bj < 2; ++bj) { const int cc = col0 + bj * 128; const f32x4 g0 = *(const f32x4*)(gate + cc), g1 = *(const f32x4*)(gate + cc + 4);
            f32x4 x0[8], x1[8];
#pragma unroll
            for (int q = 0; q < 8; ++q) { const float* xi = xrow_in(p, layer, row0 + (q >> 2) * 128 + (q & 3) * 16) + cc; x0[q] = *(const f32x4*)xi; x1[q] = *(const f32x4*)(xi + 4); }
#pragma unroll
            for (int q = 0; q < 8; ++q) { float* xo = xrow(p, row0 + (q >> 2) * 128 + (q & 3) * 16) + cc;
                *(f32x4*)xo = x0[q] + g0 * acc[q >> 2][bj][q & 3][0]; *(f32x4*)(xo + 4) = x1[q] + g1 * acc[q >> 2][bj][q & 3][1]; }
            asm volatile("" ::: "memory"); }
    }
};

constexpr int KS_STRIDE = 144, VS_STRIDE = 136, KS_BYTES = 64 * KS_STRIDE, VS_BYTES = 64 * VS_STRIDE;
constexpr int LDS_KS = 0, LDS_VS = 2 * KS_BYTES, LDS_TB = LDS_VS + 2 * VS_BYTES;

template <bool SCALED>
DI void softmax16(f32x16& x, const float c, float& m, float& l, float& alpha, bf16x8& p0, bf16x8& p1) {
    float mx = x[0];
#pragma unroll
    for (int i = 1; i < 16; ++i) mx = fmaxf(mx, x[i]);
    mx = fmaxf(mx, __shfl_xor(mx, 32));
    const float mc = SCALED ? mx : mx * c;
    const float mn = (mc > m + 8.f) ? mc : m; alpha = __builtin_amdgcn_exp2f(m - mn); m = mn;
    float s = 0.f;
#pragma unroll
    for (int i = 0; i < 16; ++i) { x[i] = __builtin_amdgcn_exp2f(SCALED ? x[i] - mn : __builtin_fmaf(x[i], c, -mn)); s += x[i]; }
    l = l * alpha + s;
    p0 = pack8(x[0], x[1], x[2], x[3], x[4], x[5], x[6], x[7]); p1 = pack8(x[8], x[9], x[10], x[11], x[12], x[13], x[14], x[15]);
}

template <int MODE>
DI void attn_unit(LAS unsigned char* lds, const Params& p, int layer, int b, int h, int kind, int qrow0, int R) {
    const int tid = ltid(p.wvid), wv = tid >> 6, lane = tid & 63, l32 = lane & 31, hh = lane >> 5;
    const bf16_t* Z = (const bf16_t*)(p.k->ws + OFF_ZQK);
    const bf16_t* VT = (const bf16_t*)(p.k->ws + OFF_VT + (MODE == 0 ? 0 : SZ_VT)) + ((size_t)b * 256 + h * 64) * KEYS;
    bf16_t* Y = (bf16_t*)(p.k->ws + OFF_YG);
    const int qcol = (MODE == 0 ? 0 : 512) + h * 64, kcol = qcol + 256, ycol = (MODE == 0 ? 0 : 256) + h * 64;
    int lo = 0, ntile;
    if (kind == 0) ntile = 36; else if (kind == 1) ntile = 4;
    else { lo = min(max(4 * R - 4, 0), 24); const int hi = min(max(4 * R - 1, 0), 24) + 7; ntile = 4 + hi - lo + 1; }
    const float c = (MODE == 0 ? 0.17677669529663687f : 0.125f) * LOG2E;
    const int nrp = wv >> 2, ng = wv & 3, rq = 4 * R + 2 * nrp + (l32 >> 4), cq = 16 * ng + (l32 & 15);
    const int r0w = min(max(rq - 4, 0), 24), c0w = min(max(cq - 8, 0), 48);
    const int r0a = min(max(4 * R + 2 * nrp - 4, 0), 24), r0b = min(max(4 * R + 2 * nrp - 3, 0), 24);
    const int cs = ng == 0 ? 0 : ng == 1 ? 8 : ng == 2 ? 24 : 32;
    const bool na = (MODE == 1 && kind == 2);
    const int qtok = na ? b * SEQ + rq * 64 + cq : qrow0 + wv * 32 + l32;
    __syncthreads();
    if (MODE == 1 && kind == 2) { const float* rp = p.k->na_rpb + ((size_t)layer * 4 + h) * 15 * 31; for (int i = tid; i < 15 * 31; i += 512) *(LAS float*)(lds + LDS_TB + i * 4) = rp[i] * LOG2E; }
    bf16x8 qf[4];
    { const bf16_t* qp = Z + (size_t)qtok * 1024 + qcol + 8 * hh;
#pragma unroll
      for (int s = 0; s < 4; ++s) qf[s] = mk8u(*(const u32x4*)(qp + 16 * s)); }
    auto tile_src = [&](int t, const bf16_t*& kp, const bf16_t*& vp, int& mrow) {
        int krow, key; mrow = -1;
        if (kind == 0) { key = 64 * t; krow = t < 32 ? b * SEQ + 64 * t : TL + b * CTX + 64 * (t - 32); }
        else if (kind == 1 || t < 4) { key = SEQ + 64 * t; krow = TL + b * CTX + 64 * t; }
        else { mrow = lo + t - 4; key = 64 * mrow; krow = b * SEQ + key; }
        kp = Z + (size_t)krow * 1024 + kcol; vp = VT + key;
    };
    const int lr = tid >> 3, lc = tid & 7;
    u32x4 kreg, vreg; const bf16_t *kp, *vp; int mrow;
    tile_src(0, kp, vp, mrow);
    kreg = *(const u32x4*)(kp + (size_t)lr * 1024 + lc * 8); vreg = *(const u32x4*)(vp + (size_t)lr * KEYS + lc * 8);
    *(LAS u32x4*)(lds + LDS_KS + lr * KS_STRIDE + lc * 16) = kreg;
    { LAS u32x2* d = (LAS u32x2*)(lds + LDS_VS + lr * VS_STRIDE + lc * 16); d[0] = mku2(vreg.x, vreg.y); d[1] = mku2(vreg.z, vreg.w); }
    __syncthreads();
    f32x16 O1[2], O2[2]; O1[0] = zero16(); O1[1] = zero16(); O2[0] = zero16(); O2[1] = zero16();
    float m1 = -1e30f, l1 = 0.f, m2 = -1e30f, l2 = 0.f;
    for (int t = 0; t < ntile; ++t) {
        const int buf = t & 1; int mr_cur = mrow;
        if (t + 1 < ntile) { tile_src(t + 1, kp, vp, mrow); kreg = *(const u32x4*)(kp + (size_t)lr * 1024 + lc * 8); vreg = *(const u32x4*)(vp + (size_t)lr * KEYS + lc * 8); }
        bool active = true;
        if (MODE == 1 && mr_cur >= 0) active = (mr_cur >= r0a) && (mr_cur < r0b + 8);
        const int nkt = (MODE == 1 && mr_cur >= 0) ? 1 : 2;
        if (active) {
#pragma nounroll
            for (int kt = 0; kt < nkt; ++kt) {
                const int koff = (MODE == 1 && mr_cur >= 0) ? cs : kt * 32;
                bf16x8 kf[4];
                { const LAS unsigned char* kb = lds + LDS_KS + buf * KS_BYTES + (koff + l32) * KS_STRIDE + 16 * hh;
#pragma unroll
                  for (int s = 0; s < 4; ++s) kf[s] = *(const LAS bf16x8*)(kb + 32 * s); }
                bf16x8 vf[2][2];
#pragma unroll
                for (int mt = 0; mt < 2; ++mt)
#pragma unroll
                    for (int sp = 0; sp < 2; ++sp) { const LAS unsigned char* vb = lds + LDS_VS + buf * VS_BYTES + (mt * 32 + l32) * VS_STRIDE + (koff + 16 * sp + 4 * hh) * 2;
                        vf[mt][sp] = mk8(*(const LAS u32x2*)vb, *(const LAS u32x2*)(vb + 16)); }
                if (MODE == 0) {
                    __builtin_amdgcn_s_setprio(1);
                    f32x16 s1 = MFMA32(kf[0], qf[0], zero16()); s1 = MFMA32(kf[1], qf[1], s1);
                    f32x16 s2 = MFMA32(kf[2], qf[2], zero16()); s2 = MFMA32(kf[3], qf[3], s2);
                    __builtin_amdgcn_s_setprio(0);
                    float a1, a2; bf16x8 p1[2], p2[2];
                    softmax16<false>(s1, c, m1, l1, a1, p1[0], p1[1]); softmax16<false>(s2, c, m2, l2, a2, p2[0], p2[1]);
                    const bool resc = __any((a1 != 1.f) || (a2 != 1.f));
#pragma unroll
                    for (int mt = 0; mt < 2; ++mt) {
                        if (resc) {
#pragma unroll
                            for (int i = 0; i < 16; ++i) { O1[mt][i] *= a1; O2[mt][i] *= a2; }
                        }
                        __builtin_amdgcn_s_setprio(1);
#pragma unroll
                        for (int sp = 0; sp < 2; ++sp) { O1[mt] = MFMA32(vf[mt][sp], p1[sp], O1[mt]); O2[mt] = MFMA32(vf[mt][sp], p2[sp], O2[mt]); }
                        __builtin_amdgcn_s_setprio(0);
                    }
                } else {
                    f32x16 s1 = MFMA32(kf[0], qf[0], zero16()); s1 = MFMA32(kf[1], qf[1], s1); s1 = MFMA32(kf[2], qf[2], s1); s1 = MFMA32(kf[3], qf[3], s1);
                    if (mr_cur >= 0) {
                        const int brow = min(max(mr_cur - rq + 7, 0), 14) * 31; const bool rv = (mr_cur >= r0w) && (mr_cur < r0w + 8);
#pragma unroll
                        for (int i = 0; i < 16; ++i) { const int kc = koff + crow(i, hh); const bool in = rv && (kc >= c0w) && (kc < c0w + 16);
                            const int bi = brow + min(max(kc - cq, -15), 15) + 15;
                            const float bv = *(const LAS float*)(lds + LDS_TB + bi * 4);
                            s1[i] = in ? s1[i] * c + bv : -1e30f; }
                    }
                    float a1; bf16x8 p1[2];
                    if (mr_cur >= 0) softmax16<true>(s1, c, m1, l1, a1, p1[0], p1[1]); else softmax16<false>(s1, c, m1, l1, a1, p1[0], p1[1]);
                    const bool resc = __any(a1 != 1.f);
#pragma unroll
                    for (int mt = 0; mt < 2; ++mt) {
                        if (resc) {
#pragma unroll
                            for (int i = 0; i < 16; ++i) O1[mt][i] *= a1;
                        }
#pragma unroll
                        for (int sp = 0; sp < 2; ++sp) O1[mt] = MFMA32(vf[mt][sp], p1[sp], O1[mt]);
                    }
                }
            }
        }
        if (t + 1 < ntile) {
            const int nb = buf ^ 1;
            *(LAS u32x4*)(lds + LDS_KS + nb * KS_BYTES + lr * KS_STRIDE + lc * 16) = kreg;
            LAS u32x2* d = (LAS u32x2*)(lds + LDS_VS + nb * VS_BYTES + lr * VS_STRIDE + lc * 16); d[0] = mku2(vreg.x, vreg.y); d[1] = mku2(vreg.z, vreg.w);
        }
        __syncthreads();
    }
    const float i1 = 1.f / (l1 + __shfl_xor(l1, 32));
    float post = 1.f; const float* gain = nullptr; float lam = 0.f, i2 = 0.f;
    if (MODE == 0) { i2 = 1.f / (l2 + __shfl_xor(l2, 32)); lam = ((const float*)(p.k->ws + OFF_MISC))[MISC_LAM + layer];
        const float lam_init = 0.8f - 0.6f * __expf(-0.3f * (float)layer); post = 1.f - lam_init; gain = p.k->da_subln_gain + layer * 64; }
    float ss = 0.f;
#pragma unroll
    for (int mt = 0; mt < 2; ++mt)
#pragma unroll
        for (int i = 0; i < 16; ++i) { float o = O1[mt][i] * i1; if (MODE == 0) o -= lam * O2[mt][i] * i2; O1[mt][i] = o; ss += o * o; }
    float rn = 1.f;
    if (MODE == 0) { ss += __shfl_xor(ss, 32); rn = rsqrtf(ss * (1.f / 64.f) + EPS) * post; }
    bf16_t* yr = Y + (size_t)qtok * 1024 + ycol;
#pragma unroll
    for (int mt = 0; mt < 2; ++mt)
#pragma unroll
        for (int g = 0; g < 4; ++g) { const int dv = 32 * mt + 8 * g + 4 * hh; u32x2* d = (u32x2*)(yr + dv); const u32x2 sg = *d;
            float o0 = O1[mt][4 * g] * rn, o1 = O1[mt][4 * g + 1] * rn, o2 = O1[mt][4 * g + 2] * rn, o3 = O1[mt][4 * g + 3] * rn;
            if (MODE == 0) { const f32x4 gv = *(const f32x4*)(gain + dv); o0 *= gv[0]; o1 *= gv[1]; o2 *= gv[2]; o3 *= gv[3]; }
            u32x2 o; o.x = pack2(o0 * bflo(sg.x), o1 * bfhi(sg.x)); o.y = pack2(o2 * bflo(sg.y), o3 * bfhi(sg.y)); *d = o; }
}

constexpr int HG_STRIDE = 136, HG_TILE = 64 * HG_STRIDE, HG_ITEM = 4 * HG_TILE, HG_EV = 2 * HG_ITEM;
DI void hgrn_item(LAS unsigned char* lds, const Params& p, int item, int islot, int wq, int lane) {
    const int b = item >> 3, h = (item >> 1) & 3, dir = item & 1, tt = wq >> 1, et = wq & 1, l32 = lane & 31, hh = lane >> 5;
    unsigned* QK = (unsigned*)(p.k->ws + OFF_G) + (size_t)dir * TT * 256 + h * 64;
    const bf16_t* KLT = (const bf16_t*)(p.k->ws + OFF_KDT) + (((size_t)dir * NB + b) * 256 + h * 64) * KEYS;
    const bf16_t* VIT = (const bf16_t*)(p.k->ws + OFF_VT + 2 * SZ_VT) + ((size_t)b * 256 + h * 64) * KEYS;
    const float* EVB = (const float*)(p.k->ws + OFF_EV) + ((size_t)dir * NB + b) * NSLOT * 3 * 256 + h * 64;
    LAS unsigned char* tl = lds + islot * HG_ITEM;
    LAS float* evl = (LAS float*)(lds + HG_EV + islot * (NSLOT * 128 * 4));
    const int t256 = wq * 64 + lane, lrow = t256 >> 3, lc = t256 & 7;
    auto chunk_pos = [&](int j, int& row0, int& kbase) {
        if (j < 4) { const int jj = dir ? 3 - j : j; row0 = TL + b * CTX + 64 * jj; kbase = SEQ + 64 * jj; }
        else { const int jj = dir ? 31 - (j - 4) : j - 4; row0 = b * SEQ + 64 * jj; kbase = 64 * jj; } };
    u32x4 pre[4][2];
    auto issue = [&](int j) { int row0, kbase; chunk_pos(j, row0, kbase);
#pragma unroll
        for (int ps = 0; ps < 2; ++ps) { const int r = lrow + 32 * ps;
            pre[0][ps] = *(const u32x4*)(QK + (size_t)(row0 + r) * 256 + lc * 4); pre[1][ps] = *(const u32x4*)(QK + (size_t)(row0 + r) * 256 + 32 + lc * 4);
            pre[2][ps] = *(const u32x4*)(KLT + (size_t)r * KEYS + kbase + lc * 8); pre[3][ps] = *(const u32x4*)(VIT + (size_t)r * KEYS + kbase + lc * 8); } };
    auto commit = [&]() {
#pragma unroll
        for (int ps = 0; ps < 2; ++ps) { const int r = lrow + 32 * ps;
#pragma unroll
            for (int k = 0; k < 2; ++k) { const u32x4 x = pre[k][ps];
                const unsigned q01 = (x.x & 0xffffu) | (x.y << 16), q23 = (x.z & 0xffffu) | (x.w << 16), k01 = (x.x >> 16) | (x.y & 0xffff0000u), k23 = (x.z >> 16) | (x.w & 0xffff0000u);
                *(LAS u32x2*)(tl + 0 * HG_TILE + r * HG_STRIDE + (32 * k + 4 * lc) * 2) = mku2(q01, q23);
                *(LAS u32x2*)(tl + 1 * HG_TILE + r * HG_STRIDE + (32 * k + 4 * lc) * 2) = mku2(k01, k23); }
#pragma unroll
            for (int t = 2; t < 4; ++t) { LAS u32x2* d = (LAS u32x2*)(tl + t * HG_TILE + r * HG_STRIDE + lc * 16); d[0] = mku2(pre[t][ps].x, pre[t][ps].y); d[1] = mku2(pre[t][ps].z, pre[t][ps].w); } } };
    __syncthreads();
    for (int i = t256; i < NSLOT * 128; i += 256) { const int sl = i >> 7, r = i & 127; evl[i] = EVB[(size_t)sl * 3 * 256 + (r >> 6) * 256 + (r & 63)]; }
    issue(0); commit();
    __syncthreads();
    f32x16 S[2]; S[0] = zero16(); S[1] = zero16();
    auto frag = [&](int tile, int row, int col) { const LAS unsigned char* a = tl + tile * HG_TILE + row * HG_STRIDE + (col + 4 * hh) * 2; return mk8(*(const LAS u32x2*)a, *(const LAS u32x2*)(a + 16)); };
    for (int j = 0; j < NSLOT; ++j) {
        int row0, kbase; chunk_pos(j, row0, kbase);
        if (j + 1 < NSLOT) issue(j + 1);
        const LAS float* ev = evl + (kbase >> 6) * 128 + 4 * hh;
        bf16x8 qp[2][2], vp[2][2];
#pragma unroll
        for (int dt = 0; dt < 2; ++dt)
#pragma unroll
            for (int sp = 0; sp < 2; ++sp) { qp[dt][sp] = frag(0, 32 * tt + l32, 32 * dt + 16 * sp); vp[dt][sp] = frag(3, 32 * et + l32, 32 * dt + 16 * sp); }
        f32x16 o = zero16();
        const int tau = 32 * tt + l32;
#pragma unroll
        for (int st = 0; st < 2; ++st) {
            f32x16 a = zero16();
#pragma unroll
            for (int dt = 0; dt < 2; ++dt)
#pragma unroll
                for (int sp = 0; sp < 2; ++sp) a = MFMA32(frag(1, 32 * st + l32, 32 * dt + 16 * sp), qp[dt][sp], a);
#pragma unroll
            for (int i = 0; i < 16; ++i) { const int sg = 32 * st + crow(i, hh); const bool keep = dir == 0 ? (sg <= tau) : (sg >= tau); a[i] = keep ? a[i] : 0.f; }
#pragma unroll
            for (int sp = 0; sp < 2; ++sp)
                o = MFMA32(pack8(a[8 * sp], a[8 * sp + 1], a[8 * sp + 2], a[8 * sp + 3], a[8 * sp + 4], a[8 * sp + 5], a[8 * sp + 6], a[8 * sp + 7]), vp[st][sp], o);
        }
#pragma unroll
        for (int dt = 0; dt < 2; ++dt) {
            float em[16];
#pragma unroll
            for (int g = 0; g < 4; ++g) { const f32x4 e4 = *(const LAS f32x4*)(ev + 64 + 32 * dt + 8 * g); em[4 * g] = e4[0]; em[4 * g + 1] = e4[1]; em[4 * g + 2] = e4[2]; em[4 * g + 3] = e4[3]; }
#pragma unroll
            for (int sp = 0; sp < 2; ++sp)
                o = MFMA32(qp[dt][sp], pack8(S[dt][8 * sp] * em[8 * sp], S[dt][8 * sp + 1] * em[8 * sp + 1], S[dt][8 * sp + 2] * em[8 * sp + 2], S[dt][8 * sp + 3] * em[8 * sp + 3],
                                             S[dt][8 * sp + 4] * em[8 * sp + 4], S[dt][8 * sp + 5] * em[8 * sp + 5], S[dt][8 * sp + 6] * em[8 * sp + 6], S[dt][8 * sp + 7] * em[8 * sp + 7]), o);
        }
#pragma unroll
        for (int i = 0; i < 16; ++i) ((bf16_t*)(QK + (size_t)(row0 + 32 * tt + crow(i, hh)) * 256 + 32 * et + l32))[0] = f2bf(o[i]);
#pragma unroll
        for (int dt = 0; dt < 2; ++dt) {
            f32x16 tmp = zero16();
#pragma unroll
            for (int st = 0; st < 2; ++st)
#pragma unroll
                for (int sp = 0; sp < 2; ++sp) tmp = MFMA32(frag(2, 32 * dt + l32, 32 * st + 16 * sp), vp[st][sp], tmp);
#pragma unroll
            for (int g = 0; g < 4; ++g) { const f32x4 eb = *(const LAS f32x4*)(ev + 32 * dt + 8 * g);
#pragma unroll
                for (int jj = 0; jj < 4; ++jj) S[dt][4 * g + jj] = eb[jj] * S[dt][4 * g + jj] + tmp[4 * g + jj]; }
        }
        __syncthreads();
        if (j + 1 < NSLOT) commit();
        __syncthreads();
    }
}

DI void phase_h(const Params& p, int layer) {
    const int lane = ltid(p.wvid) & 63, wv = ltid(p.wvid) >> 6;
    bf16_t* H = (bf16_t*)(p.k->ws + OFF_H); const float* ng = p.k->norm_gain + layer * DM;
    const int stride = gridDim.x * 8;
    for (int rowa = lbid() * 8 + wv; rowa < TT; rowa += 2 * stride) {
        f32x4 v[2][4];
#pragma unroll
        for (int r2 = 0; r2 < 2; ++r2) { const int row = rowa + r2 * stride; if (row < TT) { const float* xr = xrow_in(p, layer, row);
#pragma unroll
            for (int k = 0; k < 4; ++k) v[r2][k] = *(const f32x4*)(xr + k * 256 + lane * 4); } }
#pragma unroll
        for (int r2 = 0; r2 < 2; ++r2) { const int row = rowa + r2 * stride; if (row < TT) {
            const int bi = row < TL ? row / SEQ : 16;
            const float* mod = (const float*)(p.k->ws + OFF_MOD) + ((size_t)layer * 17 + bi) * 3072;
            float ss = 0.f;
#pragma unroll
            for (int k = 0; k < 4; ++k) ss += v[r2][k][0] * v[r2][k][0] + v[r2][k][1] * v[r2][k][1] + v[r2][k][2] * v[r2][k][2] + v[r2][k][3] * v[r2][k][3];
#pragma unroll
            for (int o = 32; o > 0; o >>= 1) ss += __shfl_xor(ss, o);
            const float r = rsqrtf(ss * (1.f / DM) + EPS);
#pragma unroll
            for (int k = 0; k < 4; ++k) { const int cc = k * 256 + lane * 4; const f32x4 g = *(const f32x4*)(ng + cc), sh = *(const f32x4*)(mod + cc), sc = *(const f32x4*)(mod + 1024 + cc);
                float o[4];
#pragma unroll
                for (int j = 0; j < 4; ++j) o[j] = v[r2][k][j] * r * g[j] * (1.f + sc[j]) + sh[j];
                u32x2 w; w.x = pack2(o[0], o[1]); w.y = pack2(o[2], o[3]); *(u32x2*)(H + (size_t)row * 1024 + cc) = w; } } }
    }
}

DI void tconv_tile(LAS unsigned char* lds, const int wvid, const float* src, int lds_src, bf16_t* dst, int ldd) {
    LAS float* t = (LAS float*)lds; const int tid = ltid(wvid);
    __syncthreads();
    { const int r = tid >> 4, c4 = (tid & 15) * 4;
#pragma unroll
      for (int rr = 0; rr < 2; ++rr) { const f32x4 v = *(const f32x4*)(src + (size_t)(r + 32 * rr) * lds_src + c4);
#pragma unroll
          for (int j = 0; j < 4; ++j) t[(r + 32 * rr) * 65 + c4 + j] = v[j]; } }
    __syncthreads();
    { const int n = tid >> 3, k0 = (tid & 7) * 8; u32x4 o;
      o.x = pack2(t[(k0) * 65 + n], t[(k0 + 1) * 65 + n]); o.y = pack2(t[(k0 + 2) * 65 + n], t[(k0 + 3) * 65 + n]);
      o.z = pack2(t[(k0 + 4) * 65 + n], t[(k0 + 5) * 65 + n]); o.w = pack2(t[(k0 + 6) * 65 + n], t[(k0 + 7) * 65 + n]);
      *(u32x4*)(dst + (size_t)n * ldd + k0) = o; }
}

DI void phase_weights(LAS unsigned char* lds, const Params& p, int layer, int jstart, int jstep) {
    unsigned char* wb = p.k->ws + wsel(layer);
    bf16_t* WIN = (bf16_t*)(wb + OFF_WIN); bf16_t* WUP = (bf16_t*)(wb + OFF_WUP); bf16_t* WM = (bf16_t*)(wb + OFF_WM); bf16_t* WO = (bf16_t*)(wb + OFF_WO);
    const float* win = p.k->w_in + (size_t)layer * 1024 * 3840; const float* wup = p.k->w_up + (size_t)layer * 4 * 256 * 1024;
    const float* wm = p.k->w_merge + (size_t)layer * 4 * 1024 * 1024; const float* wo = p.k->w_out + (size_t)layer * 1024 * 1024;
    constexpr int J_IN = 16 * 56, J_UP = 4 * 4 * 16, J_M = 4 * 16 * 16, J_O = 16 * 16, J_F = 64;
    constexpr int NJ = J_IN + J_UP + J_M + J_O + J_F;
    for (int job = jstart; job < NJ; job += jstep) {
        int j = job;
        if (j < J_IN) { const int kt = j / 56; int nt = j % 56; if (nt >= 40) nt += 4; const int n0 = nt * 64; const int dn = n0 < 2560 ? n0 : n0 + 256;
            tconv_tile(lds, p.wvid, win + (size_t)kt * 64 * 3840 + n0, 3840, WIN + (size_t)dn * 1024 + kt * 64, 1024); continue; }
        j -= J_IN;
        if (j < J_UP) { const int i = j / 64, kt = (j % 64) / 16, nt = j % 16;
            tconv_tile(lds, p.wvid, wup + (size_t)i * 256 * 1024 + (size_t)kt * 64 * 1024 + nt * 64, 1024, WUP + (size_t)nt * 64 * 1024 + i * 256 + kt * 64, 1024); continue; }
        j -= J_UP;
        if (j < J_M) { const int i = j / 256, kt = (j % 256) / 16, nt = j % 16;
            tconv_tile(lds, p.wvid, wm + (size_t)i * 1024 * 1024 + (size_t)kt * 64 * 1024 + nt * 64, 1024, WM + ((size_t)i * 1024 + nt * 64) * 1024 + kt * 64, 1024); continue; }
        j -= J_M;
        if (j < J_O) { const int kt = j / 16, nt = j % 16; tconv_tile(lds, p.wvid, wo + (size_t)kt * 64 * 1024 + nt * 64, 1024, WO + (size_t)nt * 64 * 1024 + kt * 64, 1024); continue; }
        j -= J_O;
        {
            const int kt = j >> 2, g = j & 3; LAS float* t = (LAS float*)lds; LAS float* cs = t + 64 * 65; const int tid = ltid(p.wvid);
            __syncthreads();
            { const int r = tid >> 4, c4 = (tid & 15) * 4;
#pragma unroll
              for (int rr = 0; rr < 2; ++rr) { const f32x4 v = *(const f32x4*)(win + (size_t)(kt * 64 + r + 32 * rr) * 3840 + 2560 + g * 64 + c4);
#pragma unroll
                  for (int jj = 0; jj < 4; ++jj) t[(r + 32 * rr) * 65 + c4 + jj] = v[jj]; } }
            if (tid < 64) { cs[tid] = cospif((float)tid * (1.f / 32.f)) * 0.125f; cs[64 + tid] = sinpif((float)tid * (1.f / 32.f)) * 0.125f; }
            __syncthreads();
            const int cp = tid & 63, kg = tid >> 6; float ac[8], as[8];
#pragma unroll
            for (int k = 0; k < 8; ++k) { ac[k] = 0.f; as[k] = 0.f; }
            for (int cch = 0; cch < 64; ++cch) { const int a = (cch * cp) & 63; const float cv = cs[a], sv = cs[64 + a];
#pragma unroll
                for (int k = 0; k < 8; ++k) { const float w = t[(kg * 8 + k) * 65 + cch]; ac[k] += w * cv; as[k] += w * sv; } }
            u32x4 o; o.x = pack2(ac[0], ac[1]); o.y = pack2(ac[2], ac[3]); o.z = pack2(ac[4], ac[5]); o.w = pack2(ac[6], ac[7]);
            *(u32x4*)(WIN + (size_t)(2560 + g * 64 + cp) * 1024 + kt * 64 + kg * 8) = o;
            o.x = pack2(as[0], as[1]); o.y = pack2(as[2], as[3]); o.z = pack2(as[4], as[5]); o.w = pack2(as[6], as[7]);
            *(u32x4*)(WIN + (size_t)(2816 + g * 64 + cp) * 1024 + kt * 64 + kg * 8) = o;
        }
    }
}

DI void phase_pro(LAS unsigned char* lds, const Params& p) {
    const int tid = ltid(p.wvid); const size_t gt = (size_t)lbid() * 512 + tid, gs = (size_t)gridDim.x * 512;
    float* misc = (float*)(p.k->ws + OFF_MISC);
    if (lbid() == 0) {
        { const int dir = tid >> 8, ch = tid & 255; float lg[4], mx = -1e30f;
          for (int l = 0; l < 4; ++l) { lg[l] = p.k->hg_lb_logits[(dir * 4 + l) * 256 + ch]; mx = fmaxf(mx, lg[l]); }
          float s = 0.f; for (int l = 0; l < 4; ++l) { lg[l] = expf(lg[l] - mx); s += lg[l]; }
          float cum = 0.f;
          for (int l = 0; l < 4; ++l) { if (l > 0) cum += lg[l] / s; const float lb = cum;
              misc[MISC_LOGLB + (dir * 4 + l) * 256 + ch] = logf(fmaxf(lb, 1e-20f)); misc[MISC_LOG1M + (dir * 4 + l) * 256 + ch] = log1pf(-lb); } }
        if (tid < 4) { const float* lv = p.k->da_lambda + tid * 4 * 32; float s0 = 0.f, s1 = 0.f; for (int i = 0; i < 32; ++i) { s0 += lv[i] * lv[32 + i]; s1 += lv[64 + i] * lv[96 + i]; }
            misc[MISC_LAM + tid] = expf(s0) - expf(s1) + (0.8f - 0.6f * expf(-0.3f * (float)tid)); }
        if (tid < 8) ((int*)misc)[MISC_CTR + tid] = 0;
    }
    { float* rp = (float*)(p.k->ws + OFF_ROPE);
      for (size_t i = gt; i < (size_t)2048 * 16; i += gs) { const int n = (int)(i >> 4), j = (int)(i & 15); const float inv = exp2f(-(float)(j & 7) * 1.6609640474436813f);
          const float ang = (float)(j < 8 ? (n >> 6) : (n & 63)) * inv; float sn, cs; sincosf(ang, &sn, &cs); rp[n * 32 + j] = cs; rp[n * 32 + 16 + j] = sn; } }
    { bf16_t* AL = (bf16_t*)(p.k->ws + OFF_DFTL); const float sl = 0.022097086912079608f;
      for (size_t i = gt; i < (size_t)2048 * 4096 / 8; i += gs) { const int n = (int)(i >> 9), k0 = (int)(i & 511) * 8; float v[8];
#pragma unroll
          for (int j = 0; j < 8; ++j) { const int kk = k0 + j; const int k = kk & 2047; const int r = (n * k) & 2047; const float a = (float)r * (1.f / 1024.f); v[j] = (kk < 2048 ? cospif(a) : -sinpif(a)) * sl; }
          *(u32x4*)(AL + i * 8) = __builtin_bit_cast(u32x4, pack8(v[0], v[1], v[2], v[3], v[4], v[5], v[6], v[7])); }
      bf16_t* AC = (bf16_t*)(p.k->ws + OFF_DFTC);
      for (size_t i = gt; i < (size_t)256 * 512 / 8; i += gs) { const int n = (int)(i >> 6), k0 = (int)(i & 63) * 8; float v[8];
#pragma unroll
          for (int j = 0; j < 8; ++j) { const int kk = k0 + j; const int k = kk & 255; const int r = (n * k) & 255; const float a = (float)r * (1.f / 128.f); v[j] = (kk < 256 ? cospif(a) : -sinpif(a)) * 0.0625f; }
          *(u32x4*)(AC + i * 8) = __builtin_bit_cast(u32x4, pack8(v[0], v[1], v[2], v[3], v[4], v[5], v[6], v[7])); } }
    { LAS float* sc = (LAS float*)lds;
      LAS float* red = sc + 17 * 1024;
      __syncthreads();
      for (int i = tid; i < 17 * 1024; i += 512) { const int r = i >> 10, k = i & 1023; const float v = r < 16 ? p.k->c[r * 1024 + k] : p.k->c_ctx[k]; sc[i] = v / (1.f + expf(-v)); }
      __syncthreads();
      const int wv = tid >> 6, lane = tid & 63;
      for (int job = lbid(); job < 4 * 48; job += gridDim.x) {
          const int l = job / 48, col = (job % 48) * 64 + lane; const float* w = p.k->w_mod + (size_t)l * 1024 * 3072 + col;
          float a[17];
#pragma unroll
          for (int r = 0; r < 17; ++r) a[r] = 0.f;
          for (int k0 = wv * 128; k0 < wv * 128 + 128; k0 += 16) {
              float wq[16];
#pragma unroll
              for (int q = 0; q < 16; ++q) wq[q] = w[(size_t)(k0 + q) * 3072];
#pragma unroll
              for (int q = 0; q < 16; ++q) {
#pragma unroll
                  for (int r = 0; r < 17; ++r) a[r] += sc[r * 1024 + k0 + q] * wq[q]; } }
#pragma unroll
          for (int r = 0; r < 17; ++r) red[(wv * 17 + r) * 64 + lane] = a[r];
          __syncthreads();
          for (int i = tid; i < 17 * 64; i += 512) { const int r = i >> 6, ln = i & 63; float s = 0.f;
#pragma unroll
              for (int w8 = 0; w8 < 8; ++w8) s += red[(w8 * 17 + r) * 64 + ln];
              const int cc = (job % 48) * 64 + ln; ((float*)(p.k->ws + OFF_MOD))[((size_t)l * 17 + r) * 3072 + cc] = s + p.k->b_mod[l * 3072 + cc]; }
          __syncthreads();
      } }
}

DI void phase_prep(LAS unsigned char* lds, const Params& p, int layer) {
    const int tid = ltid(p.wvid), lane = tid & 63, wv = tid >> 6;
    bf16_t* Z = (bf16_t*)(p.k->ws + OFF_ZQK);
    { const bool isA = lane < 32; const bool isK = isA ? (lane >= 16) : (lane >= 48);
      const float* gptr = isA ? p.k->da_qk_gain + (layer * 2 + (isK ? 1 : 0)) * 32 + (lane & 1) * 16 : p.k->na_qk_gain + (layer * 2 + (isK ? 1 : 0)) * 64 + (lane & 3) * 16;
      float gn[16];
#pragma unroll
      for (int j = 0; j < 16; ++j) gn[j] = gptr[j];
      const int stride = gridDim.x * 8;
      for (int rowa = lbid() * 8 + wv; rowa < TT; rowa += 2 * stride) {
          u32x4 ua[2][2];
#pragma unroll
          for (int r2 = 0; r2 < 2; ++r2) { const int row = rowa + r2 * stride; if (row < TT) { const u32x4* zq = (const u32x4*)(Z + (size_t)row * 1024 + lane * 16); ua[r2][0] = zq[0]; ua[r2][1] = zq[1]; } }
#pragma unroll
          for (int r2 = 0; r2 < 2; ++r2) { const int row = rowa + r2 * stride; if (row < TT) {
          u32x4* zp = (u32x4*)(Z + (size_t)row * 1024 + lane * 16); const u32x4 u0 = ua[r2][0], u1 = ua[r2][1];
          float v[16]; v[0] = bflo(u0.x); v[1] = bfhi(u0.x); v[2] = bflo(u0.y); v[3] = bfhi(u0.y); v[4] = bflo(u0.z); v[5] = bfhi(u0.z); v[6] = bflo(u0.w); v[7] = bfhi(u0.w);
          v[8] = bflo(u1.x); v[9] = bfhi(u1.x); v[10] = bflo(u1.y); v[11] = bfhi(u1.y); v[12] = bflo(u1.z); v[13] = bfhi(u1.z); v[14] = bflo(u1.w); v[15] = bfhi(u1.w);
          float ss = 0.f;
#pragma unroll
          for (int j = 0; j < 16; ++j) ss += v[j] * v[j];
          ss += __shfl_xor(ss, 1); const float ss2 = ss + __shfl_xor(ss, 2);
          const float r = isA ? rsqrtf(ss * (1.f / 32.f) + EPS) : rsqrtf(ss2 * (1.f / 64.f) + EPS);
#pragma unroll
          for (int j = 0; j < 16; ++j) v[j] = v[j] * r * gn[j];
          const bool rope = isA && row < TL;
          const int n = row & (SEQ - 1); const float* rt = (const float*)(p.k->ws + OFF_ROPE) + n * 32;
          float cs[16], sn[16];
#pragma unroll
          for (int j4 = 0; j4 < 4; ++j4) { f32x4 c4 = {1.f, 1.f, 1.f, 1.f}, s4 = {0.f, 0.f, 0.f, 0.f}; if (rope) { c4 = *(const f32x4*)(rt + 4 * j4); s4 = *(const f32x4*)(rt + 16 + 4 * j4); }
#pragma unroll
              for (int j = 0; j < 4; ++j) { cs[4 * j4 + j] = c4[j]; sn[4 * j4 + j] = s4[j]; } }
#pragma unroll
          for (int j = 0; j < 16; ++j) { const float other = __shfl_xor(v[j], 1);
              v[j] = (lane & 1) ? (other * sn[j] + v[j] * cs[j]) : (v[j] * cs[j] - other * sn[j]); }
          u32x4 o0, o1; o0.x = pack2(v[0], v[1]); o0.y = pack2(v[2], v[3]); o0.z = pack2(v[4], v[5]); o0.w = pack2(v[6], v[7]);
          o1.x = pack2(v[8], v[9]); o1.y = pack2(v[10], v[11]); o1.z = pack2(v[12], v[13]); o1.w = pack2(v[14], v[15]); zp[0] = o0; zp[1] = o1;
          } }
      } }
    { const bf16_t* CQ = (const bf16_t*)(p.k->ws + OFF_CQ); LAS float* part = (LAS float*)lds;
      const int ch = tid & 255, hf = tid >> 8;
      for (int item = lbid(); item < NB * NSLOT * 2; item += gridDim.x) {
          const int dir = item & 1, slot = (item >> 1) % NSLOT, b = (item >> 1) / NSLOT;
          const int row0 = slot < 32 ? b * SEQ + 64 * slot : TL + b * CTX + 64 * (slot - 32);
          float* G = (float*)(p.k->ws + OFF_G) + (size_t)dir * TT * 256 + (size_t)row0 * 256 + ch;
          const float* misc = (const float*)(p.k->ws + OFF_MISC);
          const float lbv = __expf(misc[MISC_LOGLB + (dir * 4 + layer) * 256 + ch]), omlb = __expf(misc[MISC_LOG1M + (dir * 4 + layer) * 256 + ch]);
          auto logf_gate = [&](float f) { const float sg = __builtin_amdgcn_rcpf(1.f + __builtin_amdgcn_exp2f(-1.4426950408889634f * f)); return __logf(__builtin_fmaf(omlb, sg, lbv)); };
          float ps = 0.f, gv[32];
#pragma unroll
          for (int t8 = 0; t8 < 32; t8 += 8) {
              float fv[8];
#pragma unroll
              for (int q = 0; q < 8; ++q) fv[q] = G[(size_t)(32 * hf + t8 + q) * 256];
#pragma unroll
              for (int q = 0; q < 8; ++q) { gv[t8 + q] = logf_gate(fv[q]); ps += gv[t8 + q]; }
          }
          __syncthreads(); part[hf * 256 + ch] = ps; __syncthreads();
          const float p0 = part[ch], p1 = part[256 + ch]; const float blast = p0 + p1; const float mref = dir == 0 ? p0 : p1;
          float bc = dir == 0 ? (hf ? p0 : 0.f) : (hf ? 0.f : p1); const float elm = __expf(blast - mref);
          unsigned* QK = (unsigned*)G;
          bf16_t* KDT = (bf16_t*)(p.k->ws + OFF_KDT) + (((size_t)dir * NB + b) * 256 + ch) * KEYS + 64 * slot + 32 * hf;
          const bf16_t* cq = CQ + (size_t)row0 * 256 + ch;
#pragma unroll
          for (int o8 = 0; o8 < 4; ++o8) {
              float kv[8], cqv[8];
#pragma unroll
              for (int q = 0; q < 8; ++q) { const int tl = dir == 0 ? (o8 * 8 + q) : (31 - (o8 * 8 + q)); cqv[q] = bf2f(cq[(size_t)(32 * hf + tl) * 256]); }
#pragma unroll
              for (int q = 0; q < 8; ++q) {
                  const int tl = dir == 0 ? (o8 * 8 + q) : (31 - (o8 * 8 + q)); const int tau = 32 * hf + tl;
                  const float g = dir == 0 ? gv[o8 * 8 + q] : gv[31 - (o8 * 8 + q)]; bc += g;
                  const float qv = cqv[q]; const float k = 1.f - __expf(g);
                  const float e = __expf(bc - mref); const float kdv = k * __builtin_amdgcn_rcpf(e);
                  QK[(size_t)tau * 256] = pack2(qv * e, kdv);
                  kv[dir == 0 ? q : 7 - q] = kdv * elm;
              }
              const int t8 = dir == 0 ? o8 * 8 : 24 - o8 * 8;
              *(u32x4*)(KDT + t8) = __builtin_bit_cast(u32x4, pack8(kv[0], kv[1], kv[2], kv[3], kv[4], kv[5], kv[6], kv[7]));
          }
          if (hf == 0) { float* ev = (float*)(p.k->ws + OFF_EV) + (((size_t)dir * NB + b) * NSLOT + slot) * 3 * 256 + ch; ev[0] = __expf(blast); ev[256] = __expf(mref); ev[512] = __expf(blast - mref); }
      } }
}

DI void phase_post(const Params& p, int layer) {
    const int lane = ltid(p.wvid) & 63, wv = ltid(p.wvid) >> 6;
    const unsigned* O0 = (const unsigned*)(p.k->ws + OFF_G); const unsigned* O1 = O0 + (size_t)TT * 256; bf16_t* Y = (bf16_t*)(p.k->ws + OFF_YG);
    const f32x4 gn = *(const f32x4*)(p.k->hg_norm_gain + layer * 64 + (lane & 15) * 4);
    const int stride = gridDim.x * 8;
    for (int rowa = lbid() * 8 + wv; rowa < TT; rowa += 4 * stride) {
        u32x4 a[4], bq[4]; u32x2 sgv[4];
#pragma unroll
        for (int r4 = 0; r4 < 4; ++r4) { const int row = rowa + r4 * stride; if (row < TT) { a[r4] = *(const u32x4*)(O0 + (size_t)row * 256 + lane * 4); bq[r4] = *(const u32x4*)(O1 + (size_t)row * 256 + lane * 4);
            sgv[r4] = *(const u32x2*)(Y + (size_t)row * 1024 + 512 + lane * 4); } }
#pragma unroll
        for (int r4 = 0; r4 < 4; ++r4) { const int row = rowa + r4 * stride; if (row < TT) {
            f32x4 v; v[0] = bflo(a[r4].x) + bflo(bq[r4].x); v[1] = bflo(a[r4].y) + bflo(bq[r4].y); v[2] = bflo(a[r4].z) + bflo(bq[r4].z); v[3] = bflo(a[r4].w) + bflo(bq[r4].w);
            float ss = v[0] * v[0] + v[1] * v[1] + v[2] * v[2] + v[3] * v[3];
            ss += __shfl_xor(ss, 1); ss += __shfl_xor(ss, 2); ss += __shfl_xor(ss, 4); ss += __shfl_xor(ss, 8);
            const float r = rsqrtf(ss * (1.f / 64.f) + EPS);
            const u32x2 sg = sgv[r4]; u32x2 o;
            o.x = pack2(v[0] * r * gn[0] * bflo(sg.x), v[1] * r * gn[1] * bfhi(sg.x)); o.y = pack2(v[2] * r * gn[2] * bflo(sg.y), v[3] * r * gn[3] * bfhi(sg.y));
            *(u32x2*)(Y + (size_t)row * 1024 + 512 + lane * 4) = o; } }
    }
}

DI void phase_mix(LAS unsigned char* lds, const Params& p, int layer) {
    const int tid = ltid(p.wvid), wv = tid >> 6, lane = tid & 63; const bool need_ctx = layer < DEPTH - 1;
#if defined(SELC)
    const int sel = SELC;
#elif defined(MIXSEL)
    const int sel = p.pad_ ? MIXSEL : 15;
#else
    const int sel = 15;
#endif
    if ((sel & 1) && lbid() < 64) hgrn_item(lds, p, lbid() * 2 + (wv >> 2), wv >> 2, wv & 3, lane);
    if ((sel & 2) && lbid() >= 128) {
        const int u = lbid() - 128; SchedOne S; S.u.pm = u >> 4; S.u.pn = u & 15; S.u.sub = 0; S.u.nt = 64;
        S.u.A = (const char*)(p.k->ws + OFF_DFTL) + (size_t)S.u.pm * 256 * 4096 * 2; S.u.B = (const char*)(p.k->ws + OFF_FBL) + (size_t)S.u.pn * 256 * 4096 * 2;
        EpiFour E; E.Y = (bf16_t*)(p.k->ws + OFF_YG); E.rowbase = S.u.pn * SEQ;
        gemm_phase<true>(lds, p.wvid, 4096, 4096, S, E);
        if (need_ctx && u < 16) { SchedOne S2; S2.u.pm = 0; S2.u.pn = u; S2.u.sub = 0; S2.u.nt = 8;
            S2.u.A = (const char*)(p.k->ws + OFF_DFTC); S2.u.B = (const char*)(p.k->ws + OFF_FBC) + (size_t)u * 256 * 512 * 2;
            EpiFour E2; E2.Y = E.Y; E2.rowbase = TL + u * CTX; gemm_phase<true>(lds, p.wvid, 512, 512, S2, E2); }
    }
    int* ctr = (int*)(p.k->ws + OFF_MISC) + MISC_CTR + layer + p.pad_; LAS int* slot = (LAS int*)(lds + LDS_MISC);
    const int nitems = need_ctx ? 1152 : 1024;
    __syncthreads();
    if (tid == 0) *slot = atomicAdd(ctr, 1);
    __syncthreads();
    for (;;) {
        const int it = *slot;
        __syncthreads();
        if (it >= nitems) break;
        if (tid == 0) *slot = atomicAdd(ctr, 1);
        if (it < 512 && (sel & 4)) { const int b = it >> 5, h = (it >> 3) & 3, qb = it & 7; attn_unit<0>(lds, p, layer, b, h, 0, b * SEQ + qb * 256, 0); }
        if (it >= 512 && it < 1024 && (sel & 8)) { const int j = it - 512; const int b = j >> 5, h = (j >> 3) & 3, R = j & 7; attn_unit<1>(lds, p, layer, b, h, 2, b * SEQ + R * 256, R); }
        if (it >= 1024 && it < 1088 && (sel & 4)) { const int j = it - 1024; const int b = j >> 2, h = j & 3; attn_unit<0>(lds, p, layer, b, h, 1, TL + b * CTX, 0); }
        if (it >= 1088 && (sel & 8)) { const int j = it - 1088; const int b = j >> 2, h = j & 3; attn_unit<1>(lds, p, layer, b, h, 1, TL + b * CTX, 0); }
        __syncthreads();
    }
}

DI void run_phase(LAS unsigned char* lds, const Params& pin, int ph) {
    Params p = pin; asm volatile("" : "+s"(p.k));
#ifdef ONLY
    if (ph == 0) return;
#else
    if (ph == 0) { phase_pro(lds, p); return; }
#endif
#ifdef PROBE_SUB
    const int layer = ph >= 100 ? 0 : (ph - 1) / 7, sub = ph >= 100 ? ph - 100 : (ph - 1) % 7; const bool last = layer == DEPTH - 1;
#else
    const int layer = (ph - 1) / 7, sub = (ph - 1) % 7; const bool last = layer == DEPTH - 1;
#endif
#ifdef ONLY
    if (sub != ONLY) return;
#endif
    switch (sub) {
    case 0: if (layer == 0) phase_weights(lds, p, 0, lbid(), gridDim.x); phase_h(p, layer); break;
    case 1: { SchedG1 S; S.nM = TT / 256; S.nN = 16; S.G = gridDim.x; S.c = lbid(); S.A = (const char*)(p.k->ws + OFF_H); S.B = (const char*)(p.k->ws + wsel(layer) + OFF_WIN);
        EpiG1 E; E.ws = p.k->ws; E.layer = layer; gemm_phase<true>(lds, p.wvid, 1024, 1024, S, E); } break;
    case 2: phase_prep(lds, p, layer); break;
    case 3: phase_mix(lds, p, layer); break;
    case 4: phase_post(p, layer); break;
    case 5: { SchedG2 S; S.nM = last ? TL / 256 : TT / 256; S.G = gridDim.x; S.c = lbid(); S.YG = (const char*)(p.k->ws + OFF_YG); S.WUP = (const char*)(p.k->ws + wsel(layer) + OFF_WUP);
        S.H = (const char*)(p.k->ws + OFF_H); S.WM = (const char*)(p.k->ws + wsel(layer) + OFF_WM);
        EpiG2 E; E.brs = (u32x4*)(p.k->ws + OFF_BRS) + (size_t)lbid() * 512 * 16; E.accs = (u32x4*)(p.k->ws + OFF_ACCS) + (size_t)lbid() * 512 * 16; E.ACC = (bf16_t*)(p.k->ws + OFF_ACC);
        const int su = lbid() & 63, pr = lbid() >> 6; E.t4 = (u32x4*)(p.k->ws + OFF_T4) + ((size_t)(su * 4 + pr) * 16) * 512;
        gemm_phase<true>(lds, p.wvid, 1024, 1024, S, E);
        if (!last) {
            const int tid = ltid(p.wvid); LAS unsigned* sl = (LAS unsigned*)(lds + LDS_MISC + 32);
            __syncthreads();
            if (tid == 0) { __builtin_amdgcn_fence(__ATOMIC_RELEASE, "agent"); asm volatile("s_waitcnt vmcnt(0)" ::: "memory");
                *sl = xb_add((unsigned*)(p.k->ws + OFF_BAR) + XB_SPLITCNT + layer * 64 + su, 1u); }
            __syncthreads();
            if (*sl == 3u) {
                __builtin_amdgcn_fence(__ATOMIC_ACQUIRE, "agent"); asm volatile("s_waitcnt vmcnt(0)" ::: "memory");
                int pm, pn; tile_order(2 * (int)gridDim.x + su, S.nM, 4, pm, pn);
                const int w2 = tid >> 6, fr = tid & 15, fq = (tid >> 4) & 3; const int row0 = pm * 256 + (w2 >> 2) * 64 + fr, col0 = pn * 256 + (w2 & 3) * 32 + 8 * fq;
                const u32x4* T = (const u32x4*)(p.k->ws + OFF_T4) + ((size_t)(su * 4) * 16) * 512 + tid; bf16_t* ACC = (bf16_t*)(p.k->ws + OFF_ACC);
                for (int idx = 0; idx < 16; ++idx) {
                    u32x4 tq[4];
#pragma unroll
                    for (int q = 0; q < 4; ++q) tq[q] = T[((size_t)q * 16 + idx) * 512];
                    float t[8] = {0.f, 0.f, 0.f, 0.f, 0.f, 0.f, 0.f, 0.f};
#pragma unroll
                    for (int q = 0; q < 4; ++q) { t[0] += bflo(tq[q].x); t[1] += bfhi(tq[q].x); t[2] += bflo(tq[q].y); t[3] += bfhi(tq[q].y); t[4] += bflo(tq[q].z); t[5] += bfhi(tq[q].z); t[6] += bflo(tq[q].w); t[7] += bfhi(tq[q].w); }
                    u32x4 o; o.x = pack2(t[0], t[1]); o.y = pack2(t[2], t[3]); o.z = pack2(t[4], t[5]); o.w = pack2(t[6], t[7]);
                    const int ai = idx >> 3, m = (idx >> 1) & 3, bj = idx & 1;
                    *(u32x4*)(ACC + (size_t)(row0 + ai * 128 + m * 16) * 1024 + col0 + bj * 128) = o;
                }
            }
        } }
        break;
    case 7: break;
    case 6: { SchedG3 S; S.nM = last ? TL / 256 : TT / 256; S.G = gridDim.x; S.c = lbid(); S.A = (const char*)(p.k->ws + OFF_ACC); S.B = (const char*)(p.k->ws + wsel(layer) + OFF_WO);
        EpiG3 E; E.p = p; E.layer = layer; gemm_phase<true>(lds, p.wvid, 1024, 1024, S, E);
        if (!last && lbid() >= 64) phase_weights(lds, p, layer + 1, lbid() - 64, 192); }
        break;
    }
}

constexpr int NPHASE = 1 + 7 * DEPTH;

__global__ void __launch_bounds__(512, 2) mega(KArgs ka) {
    Params p; p.k = (KPtr)__builtin_amdgcn_kernarg_segment_ptr(); p.pad_ = 0; p.wvid = __builtin_amdgcn_readfirstlane((int)threadIdx.x >> 6);
    extern __shared__ __attribute__((aligned(16))) unsigned char shm[];
    LAS unsigned char* lds = (LAS unsigned char*)shm;
#if COOP
    cg::grid_group grid = cg::this_grid();
    volatile LAS unsigned* xst = (volatile LAS unsigned*)(lds + LDS_MISC + 16);
    { const int t0 = ltid(p.wvid); if (t0 == 0) { xst[0] = 0u; xst[1] = 0u; } __syncthreads(); }
    const XcdBarrier xb = xcd_barrier_post((unsigned*)(p.k->ws + OFF_BAR), xst, ltid(p.wvid));
#ifdef PROBE_SUB
    constexpr int NPRE = 1 + PROBE_REP;
    for (int s = 0; s < NPRE + NPHASE; ++s) {
        const int ph = s < NPRE ? (s == 0 ? 0 : 100 + PROBE_SUB) : s - NPRE;
        p.pad_ = (s >= 1 && s < NPRE) ? 4 + ((s - 1) & 3) : 0;
        run_phase(lds, p, ph); if (s + 1 < NPRE + NPHASE) { if (s == 0) grid.sync(); else xcd_barrier(xb, ltid(p.wvid)); }
    }
#else
    for (int ph = p.k->phase_lo; ph < p.k->phase_hi; ++ph) { run_phase(lds, p, ph); if (ph + 1 < p.k->phase_hi) { if (ph == 0) grid.sync(); else xcd_barrier(xb, ltid(p.wvid)); } }
#endif
#else
    for (int ph = p.k->phase_lo; ph < p.k->phase_hi; ++ph) run_phase(lds, p, ph);
#endif
}

extern "C" void kernel_launch(void* const* d_in, const int* in_sizes, int n_in, void* d_out, int out_size, void* d_ws, size_t ws_size, hipStream_t stream) {
    if (ws_size < OFF_END) { fprintf(stderr, "workspace too small: %zu < %zu\n", ws_size, (size_t)OFF_END); return; }
    KArgs p{};
    const float** f = (const float**)&p;
    for (int i = 0; i < 18; ++i) f[i] = (const float*)d_in[i];
    p.out = (float*)d_out; p.ws = (unsigned char*)d_ws;
    static bool attr = false;
    if (!attr) { (void)hipFuncSetAttribute((const void*)mega, hipFuncAttributeMaxDynamicSharedMemorySize, LDS_BYTES); attr = true; }
#if COOP
    p.phase_lo = 0; p.phase_hi = NPHASE;
    (void)hipMemsetAsync((unsigned char*)d_ws + OFF_BAR, 0, 16384, stream);
    void* args[] = {&p};
    hipError_t e = hipLaunchCooperativeKernel((const void*)mega, dim3(256), dim3(512), args, LDS_BYTES, stream);
    if (e != hipSuccess) fprintf(stderr, "cooperative launch failed: %s\n", hipGetErrorString(e));
#else
    for (int ph = 0; ph < NPHASE; ++ph) { p.phase_lo = ph; p.phase_hi = ph + 1; hipLaunchKernelGGL(mega, dim3(256), dim3(512), LDS_BYTES, stream, p); }
#endif
}
```

```cpp
#include <hip/hip_runtime.h>
#include <hip/hip_cooperative_groups.h>
#include <cstdio>
namespace cg = cooperative_groups;

#ifndef COOP
#define COOP 1
#endif

#define LAS __attribute__((address_space(3)))
#define DI __device__ __forceinline__
typedef unsigned short bf16_t;
typedef short bf16x8 __attribute__((ext_vector_type(8)));
typedef float f32x4 __attribute__((ext_vector_type(4)));
typedef float f32x16 __attribute__((ext_vector_type(16)));
typedef unsigned u32x4 __attribute__((ext_vector_type(4)));
typedef unsigned u32x2 __attribute__((ext_vector_type(2)));

constexpr int DM = 1024, NB = 16, SEQ = 2048, DEPTH = 4, CTX = 256;
constexpr int TL = NB * SEQ, TC = NB * CTX, TT = TL + TC;
constexpr int KEYS = SEQ + CTX;
constexpr int NSLOT = KEYS / 64;
constexpr float EPS = 1e-6f;
constexpr float LOG2E = 1.4426950408889634f;

constexpr size_t SZ_XC = (size_t)TC * DM * 4;
constexpr size_t SZ_MOD = 1u << 20;
constexpr size_t SZ_MISC = 1u << 16;
constexpr size_t SZ_WIN = (size_t)4096 * 1024 * 2, SZ_WUP = (size_t)1024 * 1024 * 2, SZ_WM = (size_t)4096 * 1024 * 2, SZ_WO = (size_t)1024 * 1024 * 2;
constexpr size_t SZ_DFTL = (size_t)2048 * 4096 * 2, SZ_DFTC = (size_t)256 * 512 * 2;
constexpr size_t SZ_TOK256 = (size_t)TT * 256 * 2;
constexpr size_t SZ_TOK1024 = (size_t)TT * 1024 * 2;
constexpr size_t SZ_VT = (size_t)NB * 256 * KEYS * 2;
constexpr size_t SZ_EV = (size_t)2 * NB * NSLOT * 3 * 256 * 4;
constexpr size_t SZ_FBL = (size_t)4096 * 4096 * 2, SZ_FBC = (size_t)4096 * 512 * 2;
constexpr size_t SZ_G = (size_t)2 * TT * 256 * 4;
constexpr size_t SZ_SCR = (size_t)256 * 512 * 128 * 4;

constexpr size_t OFF_XC = 0;
constexpr size_t OFF_MOD = OFF_XC + SZ_XC;
constexpr size_t OFF_MISC = OFF_MOD + SZ_MOD;
constexpr size_t OFF_WIN = OFF_MISC + SZ_MISC;
constexpr size_t OFF_WUP = OFF_WIN + SZ_WIN;
constexpr size_t OFF_WM = OFF_WUP + SZ_WUP;
constexpr size_t OFF_WO = OFF_WM + SZ_WM;
constexpr size_t OFF_DFTL = OFF_WO + SZ_WO;
constexpr size_t OFF_DFTC = OFF_DFTL + SZ_DFTL;
constexpr size_t OFF_HG = OFF_DFTC + SZ_DFTC;
constexpr size_t OFF_QD = OFF_HG, OFF_KD = OFF_QD + 2 * SZ_TOK256, OFF_KDT = OFF_KD + 2 * SZ_TOK256;
constexpr size_t OFF_H = OFF_HG;
constexpr size_t OFF_EV = OFF_KDT + 2 * SZ_VT;
constexpr size_t OFF_ZQK = OFF_EV + SZ_EV;
constexpr size_t OFF_ACC = OFF_ZQK;
constexpr size_t OFF_YG = OFF_ZQK + SZ_TOK1024;
constexpr size_t OFF_VT = OFF_YG + SZ_TOK1024;
constexpr size_t OFF_FBL = OFF_VT + 3 * SZ_VT;
constexpr size_t OFF_FBC = OFF_FBL + SZ_FBL;
constexpr size_t OFF_G = OFF_FBC + SZ_FBC;
constexpr size_t OFF_O32 = OFF_G;
constexpr size_t OFF_CQ = OFF_G + SZ_G;
constexpr size_t OFF_ROPE = OFF_CQ + SZ_TOK256;
constexpr size_t OFF_BAR = OFF_ROPE + (size_t)2048 * 32 * 4;
constexpr size_t OFF_W2 = OFF_BAR + 16384;
constexpr size_t SZ_W = SZ_WIN + SZ_WUP + SZ_WM + SZ_WO;
constexpr size_t OFF_END = OFF_W2 + SZ_W;
static_assert(OFF_WUP == OFF_WIN + SZ_WIN && OFF_WM == OFF_WUP + SZ_WUP && OFF_WO == OFF_WM + SZ_WM, "weight set must be contiguous");
static_assert(OFF_END <= (size_t)536870912, "workspace budget");
constexpr size_t OFF_BRS = OFF_VT, OFF_ACCS = OFF_BRS + SZ_SCR;
constexpr size_t OFF_T4 = OFF_BRS + 33554432;
static_assert(OFF_T4 + 33554432 <= OFF_ACCS, "T4 overlaps the partial-sum stash");
constexpr int XB_SPLITCNT = 3584;
static_assert(OFF_ACCS + SZ_SCR <= OFF_ROPE, "scratch alias overflow");
static_assert(SZ_TOK1024 == 4 * SZ_TOK256, "H alias");

constexpr int MISC_LOGLB = 0;
constexpr int MISC_LOG1M = 2048;
constexpr int MISC_LAM = 4096;
constexpr int MISC_CTR = 4160;

constexpr int LDS_BYTES = 131072 + 4096;
constexpr int LDS_MISC = 131072;

struct KArgs {
    const float *x, *c, *ctx, *c_ctx, *norm_gain, *w_mod, *b_mod, *w_in, *da_qk_gain, *da_lambda, *da_subln_gain, *na_qk_gain, *na_rpb, *hg_lb_logits, *hg_norm_gain, *w_up, *w_merge, *w_out;
    float* out;
    unsigned char* ws;
    int phase_lo, phase_hi;
};
typedef const KArgs __attribute__((address_space(4)))* KPtr;
struct Params { KPtr k; int wvid, pad_; };

DI int ltid(int wvid) { int t; asm volatile("v_mbcnt_lo_u32_b32 %0, -1, 0\n\tv_mbcnt_hi_u32_b32 %0, -1, %0" : "=v"(t)); return wvid * 64 + t; }
DI int lbid() { int b = (int)blockIdx.x; asm volatile("" : "+s"(b)); return b; }
typedef float f32x2v __attribute__((ext_vector_type(2)));
typedef __bf16 bf16x2v __attribute__((ext_vector_type(2)));
DI unsigned short f2bf(float f) { __bf16 b = (__bf16)f; return __builtin_bit_cast(unsigned short, b); }
DI float bf2f(unsigned short b) { return __uint_as_float(((unsigned)b) << 16); }
DI unsigned pack2(float lo, float hi) { f32x2v v = {lo, hi}; bf16x2v r = __builtin_convertvector(v, bf16x2v); return __builtin_bit_cast(unsigned, r); }
DI float bflo(unsigned u) { return __uint_as_float(u << 16); }
DI float bfhi(unsigned u) { return __uint_as_float(u & 0xffff0000u); }
DI u32x2 mku2(unsigned a, unsigned b) { u32x2 r; r.x = a; r.y = b; return r; }
DI bf16x8 mk8(u32x2 a, u32x2 b) { u32x4 u; u.x = a.x; u.y = a.y; u.z = b.x; u.w = b.y; return __builtin_bit_cast(bf16x8, u); }
DI bf16x8 mk8u(u32x4 u) { return __builtin_bit_cast(bf16x8, u); }
DI bf16x8 pack8(float a, float b, float c, float d, float e, float f, float g, float h) { u32x4 u; u.x = pack2(a, b); u.y = pack2(c, d); u.z = pack2(e, f); u.w = pack2(g, h); return __builtin_bit_cast(bf16x8, u); }
DI float siluf(float v) { return v * __builtin_amdgcn_rcpf(1.f + __builtin_amdgcn_exp2f(-1.4426950408889634f * v)); }
DI float sigmoidf_(float v) { return __builtin_amdgcn_rcpf(1.f + __builtin_amdgcn_exp2f(-1.4426950408889634f * v)); }
DI int crow(int i, int h) { return (i & 3) + 8 * (i >> 2) + 4 * h; }
#define MFMA32(a, b, c) __builtin_amdgcn_mfma_f32_32x32x16_bf16((a), (b), (c), 0, 0, 0)
DI f32x16 zero16() { f32x16 z; for (int i = 0; i < 16; ++i) z[i] = 0.f; return z; }
DI const float* xrow_in(const Params& p, int layer, int row) {
    if (layer == 0) return row < TL ? p.k->x + (size_t)row * DM : p.k->ctx + (size_t)(row - TL) * DM;
    return row < TL ? p.k->out + (size_t)row * DM : (const float*)(p.k->ws + OFF_XC) + (size_t)(row - TL) * DM; }
DI size_t wsel(int layer) { return (layer & 1) ? (OFF_W2 - OFF_WIN) : 0; }
DI float* xrow(const Params& p, int row) { return row < TL ? p.k->out + (size_t)row * DM : (float*)(p.k->ws + OFF_XC) + (size_t)(row - TL) * DM; }

#define XB_TMO      128
#define XB_XCNT(j)  (256  + 64 * (j))
#define XB_XSUB(j)  (1280 + 64 * (j))
#define XB_XGEN(j)  (2304 + 64 * (j))
#define XB_TOP      3328
#define XB_TOPGEN   3392
#define XCD_BAR_WORDS 3456
#define XB_SPIN_CAP (1u << 18)
DI unsigned xb_ld(unsigned* p) { return __hip_atomic_load(p, __ATOMIC_RELAXED, __HIP_MEMORY_SCOPE_AGENT); }
DI unsigned xb_add(unsigned* p, unsigned v) { return __hip_atomic_fetch_add(p, v, __ATOMIC_RELAXED, __HIP_MEMORY_SCOPE_AGENT); }
DI unsigned xb_xcc_id() { return (unsigned)__builtin_amdgcn_s_getreg((3 << 11) | 20) & 0xFu; }
#define XB_SPIN(cond, bar) do { unsigned _sp = 0; while (cond) { __builtin_amdgcn_s_sleep(1); \
    if ((++_sp & 255u) == 0u) { if (xb_ld(&(bar)[XB_TMO])) break; if (_sp > XB_SPIN_CAP) { atomicAdd(&(bar)[XB_TMO], 1u); break; } } } } while (0)
struct XcdBarrier { unsigned* bar; unsigned x; volatile LAS unsigned* st; };
DI XcdBarrier xcd_barrier_post(unsigned* bar, volatile LAS unsigned* st, int tid) {
    XcdBarrier b; b.bar = bar; b.x = xb_xcc_id(); b.st = st;
    if (tid == 0) (void)xb_add(&bar[XB_XCNT(b.x)], 1u);
    return b;
}
DI void xcd_barrier_complete(unsigned* bar, unsigned x, unsigned& nloc, unsigned& nx) {
    const unsigned G = gridDim.x;
    unsigned sum, cnt, mine, sp = 0u;
    for (;;) {
        sum = 0u; cnt = 0u; mine = 0u;
#pragma unroll
        for (unsigned j = 0; j < 16; ++j) { const unsigned c = xb_ld(&bar[XB_XCNT(j)]); sum += c; cnt += (c > 0u) ? 1u : 0u; mine = (j == x) ? c : mine; }
        if (sum == G) break;
        __builtin_amdgcn_s_sleep(1);
        if ((++sp & 255u) == 0u) { if (xb_ld(&bar[XB_TMO])) break; if (sp > XB_SPIN_CAP) { atomicAdd(&bar[XB_TMO], 1u); break; } }
    }
    nloc = mine > 0u ? mine : 1u; nx = cnt > 0u ? cnt : 1u;
}
DI void xcd_barrier(const XcdBarrier& b, int tid) {
    asm volatile("s_waitcnt vmcnt(0)" ::: "memory");
    __syncthreads();
    if (tid == 0) {
        unsigned* bar = b.bar;
        __builtin_amdgcn_s_waitcnt(0);
        unsigned nloc = b.st[0], nx = b.st[1];
        if (nloc == 0u) { xcd_barrier_complete(bar, b.x, nloc, nx); b.st[0] = nloc; b.st[1] = nx; }
        const unsigned old = xb_add(&bar[XB_XSUB(b.x)], 1u);
        const unsigned gen = old / nloc;
        if (old + 1u == (gen + 1u) * nloc) {
            __builtin_amdgcn_fence(__ATOMIC_RELEASE, "agent");
            asm volatile("s_waitcnt vmcnt(0)" ::: "memory");
            const unsigned og = xb_add(&bar[XB_TOP], 1u);
            const unsigned tg = og / nx;
            if (og + 1u == (tg + 1u) * nx) xb_add(&bar[XB_TOPGEN], 1u);
            else XB_SPIN(xb_ld(&bar[XB_TOPGEN]) == tg, bar);
            __builtin_amdgcn_fence(__ATOMIC_ACQUIRE, "agent");
            xb_add(&bar[XB_XGEN(b.x)], 1u);
            asm volatile("s_waitcnt vmcnt(0)" ::: "memory");
        } else {
            XB_SPIN(xb_ld(&bar[XB_XGEN(b.x)]) == gen, bar);
            __builtin_amdgcn_fence(__ATOMIC_ACQUIRE, "agent");
            asm volatile("s_waitcnt vmcnt(0)" ::: "memory");
        }
    }
    __syncthreads();
}

constexpr int BM = 256, BK = 64, HALF = 128, HTB = HALF * BK * 2, NXCD = 8, WGM = 8;
DI int lds_byte(int r, int c) { const int st = (r >> 4) * 2 + (c >> 5), rr = r & 15, cc = c & 31, ob = rr * 64 + cc * 2; return st * 1024 + (ob ^ (((ob >> 9) & 1) << 5)); }
DI void stage_rc(int b, int& R, int& C) { const int st = b / 1024, sb = b % 1024, swz = sb ^ (((sb >> 9) & 1) << 5); R = (st >> 1) * 16 + swz / 64; C = (st & 1) * 32 + (swz % 64) / 2; }
DI int perm32(int rho) { const int n = rho >> 4, i = rho & 15; return 8 * (i >> 2) + 4 * n + (i & 3); }

struct GUnit { const char* A; const char* B; int nt, pm, pn, sub; };

DI void tile_order(int L, int nM, int nN, int& pm, int& pn) {
    const int nwg = nM * nN; int wgid = L;
    { const int q = nwg / NXCD, r = nwg % NXCD, xcd = wgid % NXCD, off = wgid / NXCD; wgid = (xcd < r ? xcd * (q + 1) : r * (q + 1) + (xcd - r) * q) + off; }
    const int nig = WGM * nN, gid = wgid / nig, fm = gid * WGM, gsz = (nM - fm) < WGM ? (nM - fm) : WGM;
    pm = fm + ((wgid % nig) % gsz); pn = (wgid % nig) / gsz;
}

template <bool PERM, class Sched, class Epi>
DI void gemm_phase(LAS unsigned char* lds, const int wvid, const int lda, const int ldb, const Sched& S, const Epi& E) {
    const int tid = ltid(wvid), wid = __builtin_amdgcn_readfirstlane(tid >> 6), lane = tid & 63, wr = wid >> 2, wc = wid & 3, fr = lane & 15, fq = lane >> 4;
    unsigned voffA[2], voffB[2];
#pragma unroll
    for (int i = 0; i < 2; ++i) { int R, C; stage_rc(tid * 16 + i * 8192, R, C); const int Rb = PERM ? ((R & ~31) + perm32(R & 31)) : R;
        voffA[i] = (unsigned)(R * lda + C) * 2u; voffB[i] = (unsigned)(Rb * ldb + C) * 2u; }
    const size_t kstep = (size_t)(BK * 2);
    const size_t hstepA = (size_t)HALF * lda * 2, hstepB = (size_t)HALF * ldb * 2;
    const unsigned ldsw = (unsigned)wid * 1024u;
    const int aoff = lds_byte(wr * 64 + fr, fq * 8), boff = lds_byte(wc * 32 + fr, fq * 8);
#define PG8_SA(b, h) (((b) * 2 + (h)) * HTB)
#define PG8_SB(b, h) ((4 + (b) * 2 + (h)) * HTB)
#define PG8_STAGE(bufoff, gbase, voff) do { _Pragma("unroll") for (int _i = 0; _i < 2; ++_i) \
        __builtin_amdgcn_global_load_lds((const unsigned*)((const char*)(gbase) + (voff)[_i]), (LAS unsigned*)(lds + (bufoff) + ldsw + _i * 8192), 16, 0, 0); } while (0)
#define PG8_LDA(dst, b, h) do { _Pragma("unroll") for (int m = 0; m < 4; ++m) _Pragma("unroll") for (int k = 0; k < 2; ++k) dst[m][k] = *(const LAS bf16x8*)(lds + PG8_SA(b, h) + aoff + m * 2048 + k * 1024); } while (0)
#define PG8_LDB(dst, b, h) do { _Pragma("unroll") for (int n = 0; n < 2; ++n) _Pragma("unroll") for (int k = 0; k < 2; ++k) dst[n][k] = *(const LAS bf16x8*)(lds + PG8_SB(b, h) + boff + n * 2048 + k * 1024); } while (0)
#define PG8_MMA(ai, bj, At, Bt) do { __builtin_amdgcn_s_setprio(1); _Pragma("unroll") for (int m = 0; m < 4; ++m) _Pragma("unroll") for (int n = 0; n < 2; ++n) _Pragma("unroll") for (int k = 0; k < 2; ++k) \
        acc[ai][bj][m][n] = __builtin_amdgcn_mfma_f32_16x16x32_bf16(Bt[n][k], At[m][k], acc[ai][bj][m][n], 0, 0, 0); __builtin_amdgcn_s_setprio(0); } while (0)
#define PG8_WAIT_V(n) asm volatile("s_waitcnt vmcnt(" #n ")" ::: "memory")
#define PG8_WAIT_L(n) asm volatile("s_waitcnt lgkmcnt(" #n ")" ::: "memory")
#define PG8_BAR __builtin_amdgcn_s_barrier()
#define PG8_SCHED __builtin_amdgcn_sched_barrier(0)
    GUnit cur, nxt; int ui = 0;
    if (!S.next(0, cur)) return;
    f32x4 acc[2][2][4][2];
#pragma unroll
    for (int a = 0; a < 2; ++a)
#pragma unroll
        for (int b = 0; b < 2; ++b)
#pragma unroll
            for (int m = 0; m < 4; ++m)
#pragma unroll
                for (int n = 0; n < 2; ++n) acc[a][b][m][n] = (f32x4){0.f, 0.f, 0.f, 0.f};
    bf16x8 At[4][2], B0[2][2], B1[2][2];
    const char* cA = cur.A; const char* cB = cur.B;
    asm volatile("" : "+s"(cA), "+s"(cB));
    PG8_STAGE(PG8_SB(0, 0), cB, voffB); PG8_STAGE(PG8_SA(0, 0), cA, voffA); PG8_STAGE(PG8_SB(0, 1), cB + hstepB, voffB); PG8_STAGE(PG8_SA(0, 1), cA + hstepA, voffA);
    if (wr == 1) PG8_BAR;
    PG8_WAIT_V(4); PG8_BAR;
    PG8_STAGE(PG8_SB(1, 0), cB + kstep, voffB); PG8_STAGE(PG8_SA(1, 0), cA + kstep, voffA); PG8_STAGE(PG8_SB(1, 1), cB + hstepB + kstep, voffB);
    PG8_WAIT_V(6); PG8_BAR;
    for (;;) {
        const bool has_next = S.next(ui + 1, nxt);
        const char* nA = has_next ? nxt.A : cA; const char* nB = has_next ? nxt.B : cB;
        asm volatile("" : "+s"(nA), "+s"(nB));
        const int nt = cur.nt;
        for (int t = 0; t < nt; t += 2) {
            const bool last = (t == nt - 2);
            const char* a1 = cA + (size_t)(t + 1) * kstep;
            const char* a2 = last ? nA : cA + (size_t)(t + 2) * kstep; const char* b2 = last ? nB : cB + (size_t)(t + 2) * kstep;
            const char* a3 = a2 + kstep; const char* b3 = b2 + kstep;
            PG8_LDB(B0, 0, 0); PG8_SCHED; PG8_LDA(At, 0, 0); PG8_STAGE(PG8_SA(1, 1), a1 + hstepA, voffA);
            PG8_WAIT_L(8); PG8_BAR; PG8_WAIT_L(0); PG8_MMA(0, 0, At, B0); PG8_BAR; PG8_SCHED;
            PG8_LDB(B1, 0, 1); PG8_STAGE(PG8_SB(0, 0), b2, voffB);
            PG8_BAR; PG8_WAIT_L(0); PG8_MMA(0, 1, At, B1); PG8_BAR;
            PG8_LDA(At, 0, 1); PG8_STAGE(PG8_SA(0, 0), a2, voffA);
            PG8_BAR; PG8_WAIT_L(0); PG8_MMA(1, 0, At, B0); PG8_BAR; PG8_SCHED;
            PG8_STAGE(PG8_SB(0, 1), b2 + hstepB, voffB);
            PG8_WAIT_V(6); PG8_BAR; PG8_MMA(1, 1, At, B1); PG8_BAR;
            PG8_LDB(B0, 1, 0); PG8_SCHED; PG8_LDA(At, 1, 0); PG8_STAGE(PG8_SA(0, 1), a2 + hstepA, voffA);
            PG8_WAIT_L(8); PG8_BAR; PG8_WAIT_L(0); PG8_MMA(0, 0, At, B0); PG8_BAR; PG8_SCHED;
            PG8_LDB(B1, 1, 1); PG8_STAGE(PG8_SB(1, 0), b3, voffB);
            PG8_BAR; PG8_WAIT_L(0); PG8_MMA(0, 1, At, B1); PG8_BAR;
            PG8_LDA(At, 1, 1); PG8_STAGE(PG8_SA(1, 0), a3, voffA);
            PG8_BAR; PG8_WAIT_L(0); PG8_MMA(1, 0, At, B0); PG8_BAR; PG8_SCHED;
            PG8_STAGE(PG8_SB(1, 1), b3 + hstepB, voffB);
            PG8_WAIT_V(6); PG8_BAR; PG8_MMA(1, 1, At, B1); PG8_BAR;
        }
        { const int t2 = ltid(wvid); const int w2 = __builtin_amdgcn_readfirstlane(t2 >> 6);
          E(acc, cur, w2 >> 2, w2 & 3, t2 & 15, (t2 >> 4) & 3); }
        if (!has_next) break;
#pragma unroll
        for (int a = 0; a < 2; ++a)
#pragma unroll
            for (int b = 0; b < 2; ++b)
#pragma unroll
                for (int m = 0; m < 4; ++m)
#pragma unroll
                    for (int n = 0; n < 2; ++n) acc[a][b][m][n] = (f32x4){0.f, 0.f, 0.f, 0.f};
        cur = nxt; cA = nA; cB = nB; ++ui;
    }
    PG8_WAIT_V(0);
    if (wr == 0) PG8_BAR;
    PG8_BAR;
#undef PG8_SA
#undef PG8_SB
#undef PG8_STAGE
#undef PG8_LDA
#undef PG8_LDB
#undef PG8_MMA
#undef PG8_WAIT_V
#undef PG8_WAIT_L
#undef PG8_BAR
#undef PG8_SCHED
}

#define EPI8_BEGIN _Pragma("unroll") for (int ai = 0; ai < 2; ++ai) _Pragma("unroll") for (int m = 0; m < 4; ++m) _Pragma("unroll") for (int bj = 0; bj < 2; ++bj) { \
    const int dr = ai * 128 + m * 16, dc = bj * 128, idx = (ai * 4 + m) * 2 + bj; const f32x4 v0 = acc[ai][bj][m][0], v1 = acc[ai][bj][m][1]; (void)dr; (void)dc; (void)idx;
#define EPI8_END asm volatile("" ::: "memory"); }

struct SchedG1 {
    int nM, nN, G, c; const char* A; const char* B;
    DI bool next(int i, GUnit& u) const {
        const int L = i * G + c; if (L >= nM * nN) return false;
        tile_order(L, nM, nN, u.pm, u.pn); u.sub = 0; u.nt = 16;
        u.A = A + (size_t)u.pm * 256 * 1024 * 2; u.B = B + (size_t)u.pn * 256 * 1024 * 2; return true;
    }
};
struct EpiG1 {
    unsigned char* ws; int layer;
    DI void operator()(const f32x4 (&acc)[2][2][4][2], const GUnit& u, int wr, int wc, int fr, int fq) const {
        const int rl0 = wr * 64 + fr, col0 = wc * 32 + 8 * fq, pm = u.pm, pn = u.pn;
        const bool lat = pm < 128; const int b = lat ? (pm >> 3) : (pm - 128);
        const int row0 = pm * 256 + rl0;
        if (pn == 7 || pn == 8) {
            float* Gp = (float*)(ws + OFF_G) + (size_t)(pn - 7) * TT * 256 + (size_t)row0 * 256 + col0;
            EPI8_BEGIN { float* d = Gp + (size_t)dr * 256 + dc; *(f32x4*)d = v0; *(f32x4*)(d + 4) = v1; } EPI8_END
        } else if (pn == 2 || pn == 5 || pn == 9 || pn == 10 || pn == 11) {
            bf16_t* base; int ldt, pos;
            if (pn >= 10) { const int part = pn - 10;
                if (lat) { base = (bf16_t*)(ws + OFF_FBL); ldt = 4096; pos = part * 2048 + (pm & 7) * 256 + rl0; }
                else { base = (bf16_t*)(ws + OFF_FBC); ldt = 512; pos = part * 256 + rl0; } }
            else { base = (bf16_t*)(ws + OFF_VT + (size_t)(pn == 2 ? 0 : pn == 5 ? 1 : 2) * SZ_VT); ldt = KEYS; pos = (lat ? (pm & 7) * 256 : SEQ) + rl0; }
            bf16_t* d0 = base + ((size_t)b * 256 + col0) * ldt + pos;
            EPI8_BEGIN { bf16_t* d = d0 + (size_t)dc * ldt + dr;
#pragma unroll
                for (int j = 0; j < 4; ++j) { d[(size_t)j * ldt] = f2bf(v0[j]); d[(size_t)(4 + j) * ldt] = f2bf(v1[j]); } } EPI8_END
        } else {
            bf16_t* d0; int ldn; bool act;
            if (pn == 6) { d0 = (bf16_t*)(ws + OFF_CQ) + col0; ldn = 256; act = true; }
            else if (pn >= 12) { d0 = (bf16_t*)(ws + OFF_YG) + (pn - 12) * 256 + col0; ldn = 1024; act = true; }
            else { d0 = (bf16_t*)(ws + OFF_ZQK) + (pn == 0 ? 0 : pn == 1 ? 256 : pn == 3 ? 512 : 768) + col0; ldn = 1024; act = false; }
            d0 += (size_t)row0 * ldn;
            if (act) { EPI8_BEGIN { u32x4 o; o.x = pack2(siluf(v0[0]), siluf(v0[1])); o.y = pack2(siluf(v0[2]), siluf(v0[3])); o.z = pack2(siluf(v1[0]), siluf(v1[1])); o.w = pack2(siluf(v1[2]), siluf(v1[3]));
                *(u32x4*)(d0 + (size_t)dr * ldn + dc) = o; } EPI8_END }
            else { EPI8_BEGIN { u32x4 o; o.x = pack2(v0[0], v0[1]); o.y = pack2(v0[2], v0[3]); o.z = pack2(v1[0], v1[1]); o.w = pack2(v1[2], v1[3]);
                *(u32x4*)(d0 + (size_t)dr * ldn + dc) = o; } EPI8_END }
        }
    }
};

struct SchedOne { GUnit u; DI bool next(int i, GUnit& o) const { if (i != 0) return false; o = u; return true; } };
struct EpiFour {
    bf16_t* Y; int rowbase;
    DI void operator()(const f32x4 (&acc)[2][2][4][2], const GUnit& u, int wr, int wc, int fr, int fq) const {
        const int r0 = rowbase + u.pm * 256 + wr * 64 + fr, c0 = 768 + wc * 32 + 8 * fq;
#pragma unroll
        for (int g8 = 0; g8 < 2; ++g8) {
            u32x4 gq[8];
#pragma unroll
            for (int q = 0; q < 8; ++q) { const int idx = g8 * 8 + q, ai = idx >> 3, m = (idx >> 1) & 3, bj = idx & 1; gq[q] = *(const u32x4*)(Y + (size_t)(r0 + ai * 128 + m * 16) * 1024 + c0 + bj * 128); }
#pragma unroll
            for (int q = 0; q < 8; ++q) { const int idx = g8 * 8 + q, ai = idx >> 3, m = (idx >> 1) & 3, bj = idx & 1; const f32x4 v0 = acc[ai][bj][m][0], v1 = acc[ai][bj][m][1]; const u32x4 g = gq[q]; u32x4 o;
                o.x = pack2(v0[0] * bflo(g.x), v0[1] * bfhi(g.x)); o.y = pack2(v0[2] * bflo(g.y), v0[3] * bfhi(g.y));
                o.z = pack2(v1[0] * bflo(g.z), v1[1] * bfhi(g.z)); o.w = pack2(v1[2] * bflo(g.w), v1[3] * bfhi(g.w));
                *(u32x4*)(Y + (size_t)(r0 + ai * 128 + m * 16) * 1024 + c0 + bj * 128) = o; }
            asm volatile("" ::: "memory");
        }
    }
};

struct SchedG2 {
    int nM, G, c; const char *YG, *WUP, *H, *WM;
    DI bool next(int i, GUnit& u) const {
        const int sup = i >> 3, sub = i & 7;
        if (sup < 2) {
            const int L = sup * G + c; if (L >= nM * 4) return false;
            tile_order(L, nM, 4, u.pm, u.pn); u.sub = sub; const int br = sub >> 1;
            if (!(sub & 1)) { u.nt = 4; u.A = YG + ((size_t)u.pm * 256 * 1024 + br * 256) * 2; u.B = WUP + ((size_t)u.pn * 256 * 1024 + br * 256) * 2; }
            else { u.nt = 16; u.A = H + (size_t)u.pm * 256 * 1024 * 2; u.B = WM + ((size_t)(br * 1024 + u.pn * 256) * 1024) * 2; }
            return true;
        }
        if (sup > 2 || sub > 1 || nM * 4 <= 2 * G) return false;
        const int L = 2 * G + (c & 63), br = c >> 6; tile_order(L, nM, 4, u.pm, u.pn); u.sub = 8 + sub;
        if (!sub) { u.nt = 4; u.A = YG + ((size_t)u.pm * 256 * 1024 + br * 256) * 2; u.B = WUP + ((size_t)u.pn * 256 * 1024 + br * 256) * 2; }
        else { u.nt = 16; u.A = H + (size_t)u.pm * 256 * 1024 * 2; u.B = WM + ((size_t)(br * 1024 + u.pn * 256) * 1024) * 2; }
        return true;
    }
};
struct EpiG2 {
    u32x4* brs; u32x4* accs; bf16_t* ACC; u32x4* t4;
    DI void operator()(const f32x4 (&acc)[2][2][4][2], const GUnit& u, int wr, int wc, int fr, int fq) const {
        const int tid = (wr * 4 + wc) * 64 + fq * 16 + fr; const int sub = u.sub;
        u32x4* B = brs + tid; u32x4* A = accs + tid;
        if (sub == 9) {
            u32x4* T = t4 + tid;
#pragma unroll
            for (int g8 = 0; g8 < 2; ++g8) {
                u32x4 bq[8];
#pragma unroll
                for (int q = 0; q < 8; ++q) bq[q] = B[(size_t)(g8 * 8 + q) * 512];
#pragma unroll
                for (int q = 0; q < 8; ++q) { const int idx = g8 * 8 + q, ai = idx >> 3, m = (idx >> 1) & 3, bj = idx & 1; const f32x4 v0 = acc[ai][bj][m][0], v1 = acc[ai][bj][m][1]; const u32x4 b = bq[q]; u32x4 o;
                    o.x = pack2(sigmoidf_(v0[0]) * bflo(b.x), sigmoidf_(v0[1]) * bfhi(b.x)); o.y = pack2(sigmoidf_(v0[2]) * bflo(b.y), sigmoidf_(v0[3]) * bfhi(b.y));
                    o.z = pack2(sigmoidf_(v1[0]) * bflo(b.z), sigmoidf_(v1[1]) * bfhi(b.z)); o.w = pack2(sigmoidf_(v1[2]) * bflo(b.w), sigmoidf_(v1[3]) * bfhi(b.w));
                    T[(size_t)idx * 512] = o; }
                asm volatile("" ::: "memory");
            }
        } else if (!(sub & 1)) {
            EPI8_BEGIN { u32x4 o; o.x = pack2(v0[0], v0[1]); o.y = pack2(v0[2], v0[3]); o.z = pack2(v1[0], v1[1]); o.w = pack2(v1[2], v1[3]); B[(size_t)idx * 512] = o; } EPI8_END
        } else {
            const int br = sub >> 1; const int row0 = u.pm * 256 + wr * 64 + fr, col0 = u.pn * 256 + wc * 32 + 8 * fq;
#pragma unroll
            for (int g8 = 0; g8 < 2; ++g8) {
                u32x4 bq[8], aq[8];
#pragma unroll
                for (int q = 0; q < 8; ++q) { bq[q] = B[(size_t)(g8 * 8 + q) * 512]; aq[q] = (u32x4){0u, 0u, 0u, 0u}; }
                if (br > 0) {
#pragma unroll
                    for (int q = 0; q < 8; ++q) aq[q] = A[(size_t)(g8 * 8 + q) * 512];
                }
#pragma unroll
                for (int q = 0; q < 8; ++q) {
                    const int idx = g8 * 8 + q, ai = idx >> 3, m = (idx >> 1) & 3, bj = idx & 1, dr = ai * 128 + m * 16, dc = bj * 128;
                    const f32x4 v0 = acc[ai][bj][m][0], v1 = acc[ai][bj][m][1]; const u32x4 b = bq[q], a = aq[q]; float t[8];
                    t[0] = sigmoidf_(v0[0]) * bflo(b.x) + bflo(a.x); t[1] = sigmoidf_(v0[1]) * bfhi(b.x) + bfhi(a.x); t[2] = sigmoidf_(v0[2]) * bflo(b.y) + bflo(a.y); t[3] = sigmoidf_(v0[3]) * bfhi(b.y) + bfhi(a.y);
                    t[4] = sigmoidf_(v1[0]) * bflo(b.z) + bflo(a.z); t[5] = sigmoidf_(v1[1]) * bfhi(b.z) + bfhi(a.z); t[6] = sigmoidf_(v1[2]) * bflo(b.w) + bflo(a.w); t[7] = sigmoidf_(v1[3]) * bfhi(b.w) + bfhi(a.w);
                    u32x4 o; o.x = pack2(t[0], t[1]); o.y = pack2(t[2], t[3]); o.z = pack2(t[4], t[5]); o.w = pack2(t[6], t[7]);
                    if (br < 3) A[(size_t)idx * 512] = o; else *(u32x4*)(ACC + (size_t)(row0 + dr) * 1024 + col0 + dc) = o;
                }
                asm volatile("" ::: "memory");
            }
        }
    }
};

struct SchedG3 {
    int nM, G, c; const char* A; const char* B;
    DI bool next(int i, GUnit& u) const {
        const int L = i * G + c; if (L >= nM * 4) return false;
        tile_order(L, nM, 4, u.pm, u.pn); u.sub = 0; u.nt = 16;
        u.A = A + (size_t)u.pm * 256 * 1024 * 2; u.B = B + (size_t)u.pn * 256 * 1024 * 2; return true;
    }
};
struct EpiG3 {
    Params p; int layer;
    DI void operator()(const f32x4 (&acc)[2][2][4][2], const GUnit& u, int wr, int wc, int fr, int fq) const {
        const int pm = u.pm; const int bi = pm < 128 ? (pm >> 3) : 16;
        const float* gate = (const float*)(p.k->ws + OFF_MOD) + ((size_t)layer * 17 + bi) * 3072 + 2048;
        const int row0 = pm * 256 + wr * 64 + fr, col0 = u.pn * 256 + wc * 32 + 8 * fq;
#pragma unroll
        for (int bj = 0; bj < 2; ++bj) { const int cc = col0 + bj * 128; const f32x4 g0 = *(const f32x4*)(gate + cc), g1 = *(const f32x4*)(gate + cc + 4);
            f32x4 x0[8], x1[8];
#pragma unroll
            for (int q = 0; q < 8; ++q) { const float* xi = xrow_in(p, layer, row0 + (q >> 2) * 128 + (q & 3) * 16) + cc; x0[q] = *(const f32x4*)xi; x1[q] = *(const f32x4*)(xi + 4); }
#pragma unroll
            for (int q = 0; q < 8; ++q) { float* xo = xrow(p, row0 + (q >> 2) * 128 + (q & 3) * 16) + cc;
                *(f32x4*)xo = x0[q] + g0 * acc[q >> 2][bj][q & 3][0]; *(f32x4*)(xo + 4) = x1[q] + g1 * acc[q >> 2][bj][q & 3][1]; }
            asm volatile("" ::: "memory"); }
    }
};

constexpr int KS_STRIDE = 144, VS_STRIDE = 136, KS_BYTES = 64 * KS_STRIDE, VS_BYTES = 64 * VS_STRIDE;
constexpr int LDS_KS = 0, LDS_VS = 2 * KS_BYTES, LDS_TB = LDS_VS + 2 * VS_BYTES;

template <bool SCALED>
DI void softmax16(f32x16& x, const float c, float& m, float& l, float& alpha, bf16x8& p0, bf16x8& p1) {
    float mx = x[0];
#pragma unroll
    for (int i = 1; i < 16; ++i) mx = fmaxf(mx, x[i]);
    mx = fmaxf(mx, __shfl_xor(mx, 32));
    const float mc = SCALED ? mx : mx * c;
    const float mn = (mc > m + 8.f) ? mc : m; alpha = __builtin_amdgcn_exp2f(m - mn); m = mn;
    float s = 0.f;
#pragma unroll
    for (int i = 0; i < 16; ++i) { x[i] = __builtin_amdgcn_exp2f(SCALED ? x[i] - mn : __builtin_fmaf(x[i], c, -mn)); s += x[i]; }
    l = l * alpha + s;
    p0 = pack8(x[0], x[1], x[2], x[3], x[4], x[5], x[6], x[7]); p1 = pack8(x[8], x[9], x[10], x[11], x[12], x[13], x[14], x[15]);
}

template <int MODE>
DI void attn_unit(LAS unsigned char* lds, const Params& p, int layer, int b, int h, int kind, int qrow0, int R) {
    const int tid = ltid(p.wvid), wv = tid >> 6, lane = tid & 63, l32 = lane & 31, hh = lane >> 5;
    const bf16_t* Z = (const bf16_t*)(p.k->ws + OFF_ZQK);
    const bf16_t* VT = (const bf16_t*)(p.k->ws + OFF_VT + (MODE == 0 ? 0 : SZ_VT)) + ((size_t)b * 256 + h * 64) * KEYS;
    bf16_t* Y = (bf16_t*)(p.k->ws + OFF_YG);
    const int qcol = (MODE == 0 ? 0 : 512) + h * 64, kcol = qcol + 256, ycol = (MODE == 0 ? 0 : 256) + h * 64;
    int lo = 0, ntile;
    if (kind == 0) ntile = 36; else if (kind == 1) ntile = 4;
    else { lo = min(max(4 * R - 4, 0), 24); const int hi = min(max(4 * R - 1, 0), 24) + 7; ntile = 4 + hi - lo + 1; }
    const float c = (MODE == 0 ? 0.17677669529663687f : 0.125f) * LOG2E;
    const int nrp = wv >> 2, ng = wv & 3, rq = 4 * R + 2 * nrp + (l32 >> 4), cq = 16 * ng + (l32 & 15);
    const int r0w = min(max(rq - 4, 0), 24), c0w = min(max(cq - 8, 0), 48);
    const int r0a = min(max(4 * R + 2 * nrp - 4, 0), 24), r0b = min(max(4 * R + 2 * nrp - 3, 0), 24);
    const int cs = ng == 0 ? 0 : ng == 1 ? 8 : ng == 2 ? 24 : 32;
    const bool na = (MODE == 1 && kind == 2);
    const int qtok = na ? b * SEQ + rq * 64 + cq : qrow0 + wv * 32 + l32;
    __syncthreads();
    if (MODE == 1 && kind == 2) { const float* rp = p.k->na_rpb + ((size_t)layer * 4 + h) * 15 * 31; for (int i = tid; i < 15 * 31; i += 512) *(LAS float*)(lds + LDS_TB + i * 4) = rp[i] * LOG2E; }
    bf16x8 qf[4];
    { const bf16_t* qp = Z + (size_t)qtok * 1024 + qcol + 8 * hh;
#pragma unroll
      for (int s = 0; s < 4; ++s) qf[s] = mk8u(*(const u32x4*)(qp + 16 * s)); }
    auto tile_src = [&](int t, const bf16_t*& kp, const bf16_t*& vp, int& mrow) {
        int krow, key; mrow = -1;
        if (kind == 0) { key = 64 * t; krow = t < 32 ? b * SEQ + 64 * t : TL + b * CTX + 64 * (t - 32); }
        else if (kind == 1 || t < 4) { key = SEQ + 64 * t; krow = TL + b * CTX + 64 * t; }
        else { mrow = lo + t - 4; key = 64 * mrow; krow = b * SEQ + key; }
        kp = Z + (size_t)krow * 1024 + kcol; vp = VT + key;
    };
    const int lr = tid >> 3, lc = tid & 7;
    u32x4 kreg, vreg; const bf16_t *kp, *vp; int mrow;
    tile_src(0, kp, vp, mrow);
    kreg = *(const u32x4*)(kp + (size_t)lr * 1024 + lc * 8); vreg = *(const u32x4*)(vp + (size_t)lr * KEYS + lc * 8);
    *(LAS u32x4*)(lds + LDS_KS + lr * KS_STRIDE + lc * 16) = kreg;
    { LAS u32x2* d = (LAS u32x2*)(lds + LDS_VS + lr * VS_STRIDE + lc * 16); d[0] = mku2(vreg.x, vreg.y); d[1] = mku2(vreg.z, vreg.w); }
    __syncthreads();
    f32x16 O1[2], O2[2]; O1[0] = zero16(); O1[1] = zero16(); O2[0] = zero16(); O2[1] = zero16();
    float m1 = -1e30f, l1 = 0.f, m2 = -1e30f, l2 = 0.f;
    for (int t = 0; t < ntile; ++t) {
        const int buf = t & 1; int mr_cur = mrow;
        if (t + 1 < ntile) { tile_src(t + 1, kp, vp, mrow); kreg = *(const u32x4*)(kp + (size_t)lr * 1024 + lc * 8); vreg = *(const u32x4*)(vp + (size_t)lr * KEYS + lc * 8); }
        bool active = true;
        if (MODE == 1 && mr_cur >= 0) active = (mr_cur >= r0a) && (mr_cur < r0b + 8);
        const int nkt = (MODE == 1 && mr_cur >= 0) ? 1 : 2;
        if (active) {
#pragma nounroll
            for (int kt = 0; kt < nkt; ++kt) {
                const int koff = (MODE == 1 && mr_cur >= 0) ? cs : kt * 32;
                bf16x8 kf[4];
                { const LAS unsigned char* kb = lds + LDS_KS + buf * KS_BYTES + (koff + l32) * KS_STRIDE + 16 * hh;
#pragma unroll
                  for (int s = 0; s < 4; ++s) kf[s] = *(const LAS bf16x8*)(kb + 32 * s); }
                bf16x8 vf[2][2];
#pragma unroll
                for (int mt = 0; mt < 2; ++mt)
#pragma unroll
                    for (int sp = 0; sp < 2; ++sp) { const LAS unsigned char* vb = lds + LDS_VS + buf * VS_BYTES + (mt * 32 + l32) * VS_STRIDE + (koff + 16 * sp + 4 * hh) * 2;
                        vf[mt][sp] = mk8(*(const LAS u32x2*)vb, *(const LAS u32x2*)(vb + 16)); }
                if (MODE == 0) {
                    f32x16 s1 = MFMA32(kf[0], qf[0], zero16()); s1 = MFMA32(kf[1], qf[1], s1);
                    f32x16 s2 = MFMA32(kf[2], qf[2], zero16()); s2 = MFMA32(kf[3], qf[3], s2);
                    float a1, a2; bf16x8 p1[2], p2[2];
                    softmax16<false>(s1, c, m1, l1, a1, p1[0], p1[1]); softmax16<false>(s2, c, m2, l2, a2, p2[0], p2[1]);
                    const bool resc = __any((a1 != 1.f) || (a2 != 1.f));
#pragma unroll
                    for (int mt = 0; mt < 2; ++mt) {
                        if (resc) {
#pragma unroll
                            for (int i = 0; i < 16; ++i) { O1[mt][i] *= a1; O2[mt][i] *= a2; }
                        }
#pragma unroll
                        for (int sp = 0; sp < 2; ++sp) { O1[mt] = MFMA32(vf[mt][sp], p1[sp], O1[mt]); O2[mt] = MFMA32(vf[mt][sp], p2[sp], O2[mt]); }
                    }
                } else {
                    f32x16 s1 = MFMA32(kf[0], qf[0], zero16()); s1 = MFMA32(kf[1], qf[1], s1); s1 = MFMA32(kf[2], qf[2], s1); s1 = MFMA32(kf[3], qf[3], s1);
                    if (mr_cur >= 0) {
                        const int brow = min(max(mr_cur - rq + 7, 0), 14) * 31; const bool rv = (mr_cur >= r0w) && (mr_cur < r0w + 8);
#pragma unroll
                        for (int i = 0; i < 16; ++i) { const int kc = koff + crow(i, hh); const bool in = rv && (kc >= c0w) && (kc < c0w + 16);
                            const int bi = brow + min(max(kc - cq, -15), 15) + 15;
                            const float bv = *(const LAS float*)(lds + LDS_TB + bi * 4);
                            s1[i] = in ? s1[i] * c + bv : -1e30f; }
                    }
                    float a1; bf16x8 p1[2];
                    if (mr_cur >= 0) softmax16<true>(s1, c, m1, l1, a1, p1[0], p1[1]); else softmax16<false>(s1, c, m1, l1, a1, p1[0], p1[1]);
                    const bool resc = __any(a1 != 1.f);
#pragma unroll
                    for (int mt = 0; mt < 2; ++mt) {
                        if (resc) {
#pragma unroll
                            for (int i = 0; i < 16; ++i) O1[mt][i] *= a1;
                        }
#pragma unroll
                        for (int sp = 0; sp < 2; ++sp) O1[mt] = MFMA32(vf[mt][sp], p1[sp], O1[mt]);
                    }
                }
            }
        }
        if (t + 1 < ntile) {
            const int nb = buf ^ 1;
            *(LAS u32x4*)(lds + LDS_KS + nb * KS_BYTES + lr * KS_STRIDE + lc * 16) = kreg;
            LAS u32x2* d = (LAS u32x2*)(lds + LDS_VS + nb * VS_BYTES + lr * VS_STRIDE + lc * 16); d[0] = mku2(vreg.x, vreg.y); d[1] = mku2(vreg.z, vreg.w);
        }
        __syncthreads();
    }
    const float i1 = 1.f / (l1 + __shfl_xor(l1, 32));
    float post = 1.f; const float* gain = nullptr; float lam = 0.f, i2 = 0.f;
    if (MODE == 0) { i2 = 1.f / (l2 + __shfl_xor(l2, 32)); lam = ((const float*)(p.k->ws + OFF_MISC))[MISC_LAM + layer];
        const float lam_init = 0.8f - 0.6f * __expf(-0.3f * (float)layer); post = 1.f - lam_init; gain = p.k->da_subln_gain + layer * 64; }
    float ss = 0.f;
#pragma unroll
    for (int mt = 0; mt < 2; ++mt)
#pragma unroll
        for (int i = 0; i < 16; ++i) { float o = O1[mt][i] * i1; if (MODE == 0) o -= lam * O2[mt][i] * i2; O1[mt][i] = o; ss += o * o; }
    float rn = 1.f;
    if (MODE == 0) { ss += __shfl_xor(ss, 32); rn = rsqrtf(ss * (1.f / 64.f) + EPS) * post; }
    bf16_t* yr = Y + (size_t)qtok * 1024 + ycol;
#pragma unroll
    for (int mt = 0; mt < 2; ++mt)
#pragma unroll
        for (int g = 0; g < 4; ++g) { const int dv = 32 * mt + 8 * g + 4 * hh; u32x2* d = (u32x2*)(yr + dv); const u32x2 sg = *d;
            float o0 = O1[mt][4 * g] * rn, o1 = O1[mt][4 * g + 1] * rn, o2 = O1[mt][4 * g + 2] * rn, o3 = O1[mt][4 * g + 3] * rn;
            if (MODE == 0) { const f32x4 gv = *(const f32x4*)(gain + dv); o0 *= gv[0]; o1 *= gv[1]; o2 *= gv[2]; o3 *= gv[3]; }
            u32x2 o; o.x = pack2(o0 * bflo(sg.x), o1 * bfhi(sg.x)); o.y = pack2(o2 * bflo(sg.y), o3 * bfhi(sg.y)); *d = o; }
}

constexpr int HG_STRIDE = 136, HG_TILE = 64 * HG_STRIDE, HG_ITEM = 4 * HG_TILE, HG_EV = 2 * HG_ITEM;
DI void hgrn_item(LAS unsigned char* lds, const Params& p, int item, int islot, int wq, int lane) {
    const int b = item >> 3, h = (item >> 1) & 3, dir = item & 1, tt = wq >> 1, et = wq & 1, l32 = lane & 31, hh = lane >> 5;
    unsigned* QK = (unsigned*)(p.k->ws + OFF_G) + (size_t)dir * TT * 256 + h * 64;
    const bf16_t* KLT = (const bf16_t*)(p.k->ws + OFF_KDT) + (((size_t)dir * NB + b) * 256 + h * 64) * KEYS;
    const bf16_t* VIT = (const bf16_t*)(p.k->ws + OFF_VT + 2 * SZ_VT) + ((size_t)b * 256 + h * 64) * KEYS;
    const float* EVB = (const float*)(p.k->ws + OFF_EV) + ((size_t)dir * NB + b) * NSLOT * 3 * 256 + h * 64;
    LAS unsigned char* tl = lds + islot * HG_ITEM;
    LAS float* evl = (LAS float*)(lds + HG_EV + islot * (NSLOT * 128 * 4));
    const int t256 = wq * 64 + lane, lrow = t256 >> 3, lc = t256 & 7;
    auto chunk_pos = [&](int j, int& row0, int& kbase) {
        if (j < 4) { const int jj = dir ? 3 - j : j; row0 = TL + b * CTX + 64 * jj; kbase = SEQ + 64 * jj; }
        else { const int jj = dir ? 31 - (j - 4) : j - 4; row0 = b * SEQ + 64 * jj; kbase = 64 * jj; } };
    u32x4 pre[4][2];
    auto issue = [&](int j) { int row0, kbase; chunk_pos(j, row0, kbase);
#pragma unroll
        for (int ps = 0; ps < 2; ++ps) { const int r = lrow + 32 * ps;
            pre[0][ps] = *(const u32x4*)(QK + (size_t)(row0 + r) * 256 + lc * 4); pre[1][ps] = *(const u32x4*)(QK + (size_t)(row0 + r) * 256 + 32 + lc * 4);
            pre[2][ps] = *(const u32x4*)(KLT + (size_t)r * KEYS + kbase + lc * 8); pre[3][ps] = *(const u32x4*)(VIT + (size_t)r * KEYS + kbase + lc * 8); } };
    auto commit = [&]() {
#pragma unroll
        for (int ps = 0; ps < 2; ++ps) { const int r = lrow + 32 * ps;
#pragma unroll
            for (int k = 0; k < 2; ++k) { const u32x4 x = pre[k][ps];
                const unsigned q01 = (x.x & 0xffffu) | (x.y << 16), q23 = (x.z & 0xffffu) | (x.w << 16), k01 = (x.x >> 16) | (x.y & 0xffff0000u), k23 = (x.z >> 16) | (x.w & 0xffff0000u);
                *(LAS u32x2*)(tl + 0 * HG_TILE + r * HG_STRIDE + (32 * k + 4 * lc) * 2) = mku2(q01, q23);
                *(LAS u32x2*)(tl + 1 * HG_TILE + r * HG_STRIDE + (32 * k + 4 * lc) * 2) = mku2(k01, k23); }
#pragma unroll
            for (int t = 2; t < 4; ++t) { LAS u32x2* d = (LAS u32x2*)(tl + t * HG_TILE + r * HG_STRIDE + lc * 16); d[0] = mku2(pre[t][ps].x, pre[t][ps].y); d[1] = mku2(pre[t][ps].z, pre[t][ps].w); } } };
    __syncthreads();
    for (int i = t256; i < NSLOT * 128; i += 256) { const int sl = i >> 7, r = i & 127; evl[i] = EVB[(size_t)sl * 3 * 256 + (r >> 6) * 256 + (r & 63)]; }
    issue(0); commit();
    __syncthreads();
    f32x16 S[2]; S[0] = zero16(); S[1] = zero16();
    auto frag = [&](int tile, int row, int col) { const LAS unsigned char* a = tl + tile * HG_TILE + row * HG_STRIDE + (col + 4 * hh) * 2; return mk8(*(const LAS u32x2*)a, *(const LAS u32x2*)(a + 16)); };
    for (int j = 0; j < NSLOT; ++j) {
        int row0, kbase; chunk_pos(j, row0, kbase);
        if (j + 1 < NSLOT) issue(j + 1);
        const LAS float* ev = evl + (kbase >> 6) * 128 + 4 * hh;
        bf16x8 qp[2][2], vp[2][2];
#pragma unroll
        for (int dt = 0; dt < 2; ++dt)
#pragma unroll
            for (int sp = 0; sp < 2; ++sp) { qp[dt][sp] = frag(0, 32 * tt + l32, 32 * dt + 16 * sp); vp[dt][sp] = frag(3, 32 * et + l32, 32 * dt + 16 * sp); }
        f32x16 o = zero16();
        const int tau = 32 * tt + l32;
#pragma unroll
        for (int st = 0; st < 2; ++st) {
            f32x16 a = zero16();
#pragma unroll
            for (int dt = 0; dt < 2; ++dt)
#pragma unroll
                for (int sp = 0; sp < 2; ++sp) a = MFMA32(frag(1, 32 * st + l32, 32 * dt + 16 * sp), qp[dt][sp], a);
#pragma unroll
            for (int i = 0; i < 16; ++i) { const int sg = 32 * st + crow(i, hh); const bool keep = dir == 0 ? (sg <= tau) : (sg >= tau); a[i] = keep ? a[i] : 0.f; }
#pragma unroll
            for (int sp = 0; sp < 2; ++sp)
                o = MFMA32(pack8(a[8 * sp], a[8 * sp + 1], a[8 * sp + 2], a[8 * sp + 3], a[8 * sp + 4], a[8 * sp + 5], a[8 * sp + 6], a[8 * sp + 7]), vp[st][sp], o);
        }
#pragma unroll
        for (int dt = 0; dt < 2; ++dt) {
            float em[16];
#pragma unroll
            for (int g = 0; g < 4; ++g) { const f32x4 e4 = *(const LAS f32x4*)(ev + 64 + 32 * dt + 8 * g); em[4 * g] = e4[0]; em[4 * g + 1] = e4[1]; em[4 * g + 2] = e4[2]; em[4 * g + 3] = e4[3]; }
#pragma unroll
            for (int sp = 0; sp < 2; ++sp)
                o = MFMA32(qp[dt][sp], pack8(S[dt][8 * sp] * em[8 * sp], S[dt][8 * sp + 1] * em[8 * sp + 1], S[dt][8 * sp + 2] * em[8 * sp + 2], S[dt][8 * sp + 3] * em[8 * sp + 3],
                                             S[dt][8 * sp + 4] * em[8 * sp + 4], S[dt][8 * sp + 5] * em[8 * sp + 5], S[dt][8 * sp + 6] * em[8 * sp + 6], S[dt][8 * sp + 7] * em[8 * sp + 7]), o);
        }
#pragma unroll
        for (int i = 0; i < 16; ++i) ((bf16_t*)(QK + (size_t)(row0 + 32 * tt + crow(i, hh)) * 256 + 32 * et + l32))[0] = f2bf(o[i]);
#pragma unroll
        for (int dt = 0; dt < 2; ++dt) {
            f32x16 tmp = zero16();
#pragma unroll
            for (int st = 0; st < 2; ++st)
#pragma unroll
                for (int sp = 0; sp < 2; ++sp) tmp = MFMA32(frag(2, 32 * dt + l32, 32 * st + 16 * sp), vp[st][sp], tmp);
#pragma unroll
            for (int g = 0; g < 4; ++g) { const f32x4 eb = *(const LAS f32x4*)(ev + 32 * dt + 8 * g);
#pragma unroll
                for (int jj = 0; jj < 4; ++jj) S[dt][4 * g + jj] = eb[jj] * S[dt][4 * g + jj] + tmp[4 * g + jj]; }
        }
        __syncthreads();
        if (j + 1 < NSLOT) commit();
        __syncthreads();
    }
}

DI void phase_h(const Params& p, int layer) {
    const int lane = ltid(p.wvid) & 63, wv = ltid(p.wvid) >> 6;
    bf16_t* H = (bf16_t*)(p.k->ws + OFF_H); const float* ng = p.k->norm_gain + layer * DM;
    const int stride = gridDim.x * 8;
    for (int rowa = lbid() * 8 + wv; rowa < TT; rowa += 2 * stride) {
        f32x4 v[2][4];
#pragma unroll
        for (int r2 = 0; r2 < 2; ++r2) { const int row = rowa + r2 * stride; if (row < TT) { const float* xr = xrow_in(p, layer, row);
#pragma unroll
            for (int k = 0; k < 4; ++k) v[r2][k] = *(const f32x4*)(xr + k * 256 + lane * 4); } }
#pragma unroll
        for (int r2 = 0; r2 < 2; ++r2) { const int row = rowa + r2 * stride; if (row < TT) {
            const int bi = row < TL ? row / SEQ : 16;
            const float* mod = (const float*)(p.k->ws + OFF_MOD) + ((size_t)layer * 17 + bi) * 3072;
            float ss = 0.f;
#pragma unroll
            for (int k = 0; k < 4; ++k) ss += v[r2][k][0] * v[r2][k][0] + v[r2][k][1] * v[r2][k][1] + v[r2][k][2] * v[r2][k][2] + v[r2][k][3] * v[r2][k][3];
#pragma unroll
            for (int o = 32; o > 0; o >>= 1) ss += __shfl_xor(ss, o);
            const float r = rsqrtf(ss * (1.f / DM) + EPS);
#pragma unroll
            for (int k = 0; k < 4; ++k) { const int cc = k * 256 + lane * 4; const f32x4 g = *(const f32x4*)(ng + cc), sh = *(const f32x4*)(mod + cc), sc = *(const f32x4*)(mod + 1024 + cc);
                float o[4];
#pragma unroll
                for (int j = 0; j < 4; ++j) o[j] = v[r2][k][j] * r * g[j] * (1.f + sc[j]) + sh[j];
                u32x2 w; w.x = pack2(o[0], o[1]); w.y = pack2(o[2], o[3]); *(u32x2*)(H + (size_t)row * 1024 + cc) = w; } } }
    }
}

DI void tconv_tile(LAS unsigned char* lds, const int wvid, const float* src, int lds_src, bf16_t* dst, int ldd) {
    LAS float* t = (LAS float*)lds; const int tid = ltid(wvid);
    __syncthreads();
    { const int r = tid >> 4, c4 = (tid & 15) * 4;
#pragma unroll
      for (int rr = 0; rr < 2; ++rr) { const f32x4 v = *(const f32x4*)(src + (size_t)(r + 32 * rr) * lds_src + c4);
#pragma unroll
          for (int j = 0; j < 4; ++j) t[(r + 32 * rr) * 65 + c4 + j] = v[j]; } }
    __syncthreads();
    { const int n = tid >> 3, k0 = (tid & 7) * 8; u32x4 o;
      o.x = pack2(t[(k0) * 65 + n], t[(k0 + 1) * 65 + n]); o.y = pack2(t[(k0 + 2) * 65 + n], t[(k0 + 3) * 65 + n]);
      o.z = pack2(t[(k0 + 4) * 65 + n], t[(k0 + 5) * 65 + n]); o.w = pack2(t[(k0 + 6) * 65 + n], t[(k0 + 7) * 65 + n]);
      *(u32x4*)(dst + (size_t)n * ldd + k0) = o; }
}

DI void phase_weights(LAS unsigned char* lds, const Params& p, int layer, int jstart, int jstep) {
    unsigned char* wb = p.k->ws + wsel(layer);
    bf16_t* WIN = (bf16_t*)(wb + OFF_WIN); bf16_t* WUP = (bf16_t*)(wb + OFF_WUP); bf16_t* WM = (bf16_t*)(wb + OFF_WM); bf16_t* WO = (bf16_t*)(wb + OFF_WO);
    const float* win = p.k->w_in + (size_t)layer * 1024 * 3840; const float* wup = p.k->w_up + (size_t)layer * 4 * 256 * 1024;
    const float* wm = p.k->w_merge + (size_t)layer * 4 * 1024 * 1024; const float* wo = p.k->w_out + (size_t)layer * 1024 * 1024;
    constexpr int J_IN = 16 * 56, J_UP = 4 * 4 * 16, J_M = 4 * 16 * 16, J_O = 16 * 16, J_F = 64;
    constexpr int NJ = J_IN + J_UP + J_M + J_O + J_F;
    for (int job = jstart; job < NJ; job += jstep) {
        int j = job;
        if (j < J_IN) { const int kt = j / 56; int nt = j % 56; if (nt >= 40) nt += 4; const int n0 = nt * 64; const int dn = n0 < 2560 ? n0 : n0 + 256;
            tconv_tile(lds, p.wvid, win + (size_t)kt * 64 * 3840 + n0, 3840, WIN + (size_t)dn * 1024 + kt * 64, 1024); continue; }
        j -= J_IN;
        if (j < J_UP) { const int i = j / 64, kt = (j % 64) / 16, nt = j % 16;
            tconv_tile(lds, p.wvid, wup + (size_t)i * 256 * 1024 + (size_t)kt * 64 * 1024 + nt * 64, 1024, WUP + (size_t)nt * 64 * 1024 + i * 256 + kt * 64, 1024); continue; }
        j -= J_UP;
        if (j < J_M) { const int i = j / 256, kt = (j % 256) / 16, nt = j % 16;
            tconv_tile(lds, p.wvid, wm + (size_t)i * 1024 * 1024 + (size_t)kt * 64 * 1024 + nt * 64, 1024, WM + ((size_t)i * 1024 + nt * 64) * 1024 + kt * 64, 1024); continue; }
        j -= J_M;
        if (j < J_O) { const int kt = j / 16, nt = j % 16; tconv_tile(lds, p.wvid, wo + (size_t)kt * 64 * 1024 + nt * 64, 1024, WO + (size_t)nt * 64 * 1024 + kt * 64, 1024); continue; }
        j -= J_O;
        {
            const int kt = j >> 2, g = j & 3; LAS float* t = (LAS float*)lds; LAS float* cs = t + 64 * 65; const int tid = ltid(p.wvid);
            __syncthreads();
            { const int r = tid >> 4, c4 = (tid & 15) * 4;
#pragma unroll
              for (int rr = 0; rr < 2; ++rr) { const f32x4 v = *(const f32x4*)(win + (size_t)(kt * 64 + r + 32 * rr) * 3840 + 2560 + g * 64 + c4);
#pragma unroll
                  for (int jj = 0; jj < 4; ++jj) t[(r + 32 * rr) * 65 + c4 + jj] = v[jj]; } }
            if (tid < 64) { cs[tid] = cospif((float)tid * (1.f / 32.f)) * 0.125f; cs[64 + tid] = sinpif((float)tid * (1.f / 32.f)) * 0.125f; }
            __syncthreads();
            const int cp = tid & 63, kg = tid >> 6; float ac[8], as[8];
#pragma unroll
            for (int k = 0; k < 8; ++k) { ac[k] = 0.f; as[k] = 0.f; }
            for (int cch = 0; cch < 64; ++cch) { const int a = (cch * cp) & 63; const float cv = cs[a], sv = cs[64 + a];
#pragma unroll
                for (int k = 0; k < 8; ++k) { const float w = t[(kg * 8 + k) * 65 + cch]; ac[k] += w * cv; as[k] += w * sv; } }
            u32x4 o; o.x = pack2(ac[0], ac[1]); o.y = pack2(ac[2], ac[3]); o.z = pack2(ac[4], ac[5]); o.w = pack2(ac[6], ac[7]);
            *(u32x4*)(WIN + (size_t)(2560 + g * 64 + cp) * 1024 + kt * 64 + kg * 8) = o;
            o.x = pack2(as[0], as[1]); o.y = pack2(as[2], as[3]); o.z = pack2(as[4], as[5]); o.w = pack2(as[6], as[7]);
            *(u32x4*)(WIN + (size_t)(2816 + g * 64 + cp) * 1024 + kt * 64 + kg * 8) = o;
        }
    }
}

DI void phase_pro(LAS unsigned char* lds, const Params& p) {
    const int tid = ltid(p.wvid); const size_t gt = (size_t)lbid() * 512 + tid, gs = (size_t)gridDim.x * 512;
    float* misc = (float*)(p.k->ws + OFF_MISC);
    if (lbid() == 0) {
        { const int dir = tid >> 8, ch = tid & 255; float lg[4], mx = -1e30f;
          for (int l = 0; l < 4; ++l) { lg[l] = p.k->hg_lb_logits[(dir * 4 + l) * 256 + ch]; mx = fmaxf(mx, lg[l]); }
          float s = 0.f; for (int l = 0; l < 4; ++l) { lg[l] = expf(lg[l] - mx); s += lg[l]; }
          float cum = 0.f;
          for (int l = 0; l < 4; ++l) { if (l > 0) cum += lg[l] / s; const float lb = cum;
              misc[MISC_LOGLB + (dir * 4 + l) * 256 + ch] = logf(fmaxf(lb, 1e-20f)); misc[MISC_LOG1M + (dir * 4 + l) * 256 + ch] = log1pf(-lb); } }
        if (tid < 4) { const float* lv = p.k->da_lambda + tid * 4 * 32; float s0 = 0.f, s1 = 0.f; for (int i = 0; i < 32; ++i) { s0 += lv[i] * lv[32 + i]; s1 += lv[64 + i] * lv[96 + i]; }
            misc[MISC_LAM + tid] = expf(s0) - expf(s1) + (0.8f - 0.6f * expf(-0.3f * (float)tid)); }
        if (tid < 8) ((int*)misc)[MISC_CTR + tid] = 0;
    }
    { float* rp = (float*)(p.k->ws + OFF_ROPE);
      for (size_t i = gt; i < (size_t)2048 * 16; i += gs) { const int n = (int)(i >> 4), j = (int)(i & 15); const float inv = exp2f(-(float)(j & 7) * 1.6609640474436813f);
          const float ang = (float)(j < 8 ? (n >> 6) : (n & 63)) * inv; float sn, cs; sincosf(ang, &sn, &cs); rp[n * 32 + j] = cs; rp[n * 32 + 16 + j] = sn; } }
    { bf16_t* AL = (bf16_t*)(p.k->ws + OFF_DFTL); const float sl = 0.022097086912079608f;
      for (size_t i = gt; i < (size_t)2048 * 4096 / 8; i += gs) { const int n = (int)(i >> 9), k0 = (int)(i & 511) * 8; float v[8];
#pragma unroll
          for (int j = 0; j < 8; ++j) { const int kk = k0 + j; const int k = kk & 2047; const int r = (n * k) & 2047; const float a = (float)r * (1.f / 1024.f); v[j] = (kk < 2048 ? cospif(a) : -sinpif(a)) * sl; }
          *(u32x4*)(AL + i * 8) = __builtin_bit_cast(u32x4, pack8(v[0], v[1], v[2], v[3], v[4], v[5], v[6], v[7])); }
      bf16_t* AC = (bf16_t*)(p.k->ws + OFF_DFTC);
      for (size_t i = gt; i < (size_t)256 * 512 / 8; i += gs) { const int n = (int)(i >> 6), k0 = (int)(i & 63) * 8; float v[8];
#pragma unroll
          for (int j = 0; j < 8; ++j) { const int kk = k0 + j; const int k = kk & 255; const int r = (n * k) & 255; const float a = (float)r * (1.f / 128.f); v[j] = (kk < 256 ? cospif(a) : -sinpif(a)) * 0.0625f; }
          *(u32x4*)(AC + i * 8) = __builtin_bit_cast(u32x4, pack8(v[0], v[1], v[2], v[3], v[4], v[5], v[6], v[7])); } }
    { LAS float* sc = (LAS float*)lds;
      LAS float* red = sc + 17 * 1024;
      __syncthreads();
      for (int i = tid; i < 17 * 1024; i += 512) { const int r = i >> 10, k = i & 1023; const float v = r < 16 ? p.k->c[r * 1024 + k] : p.k->c_ctx[k]; sc[i] = v / (1.f + expf(-v)); }
      __syncthreads();
      const int wv = tid >> 6, lane = tid & 63;
      for (int job = lbid(); job < 4 * 48; job += gridDim.x) {
          const int l = job / 48, col = (job % 48) * 64 + lane; const float* w = p.k->w_mod + (size_t)l * 1024 * 3072 + col;
          float a[17];
#pragma unroll
          for (int r = 0; r < 17; ++r) a[r] = 0.f;
          for (int k0 = wv * 128; k0 < wv * 128 + 128; k0 += 16) {
              float wq[16];
#pragma unroll
              for (int q = 0; q < 16; ++q) wq[q] = w[(size_t)(k0 + q) * 3072];
#pragma unroll
              for (int q = 0; q < 16; ++q) {
#pragma unroll
                  for (int r = 0; r < 17; ++r) a[r] += sc[r * 1024 + k0 + q] * wq[q]; } }
#pragma unroll
          for (int r = 0; r < 17; ++r) red[(wv * 17 + r) * 64 + lane] = a[r];
          __syncthreads();
          for (int i = tid; i < 17 * 64; i += 512) { const int r = i >> 6, ln = i & 63; float s = 0.f;
#pragma unroll
              for (int w8 = 0; w8 < 8; ++w8) s += red[(w8 * 17 + r) * 64 + ln];
              const int cc = (job % 48) * 64 + ln; ((float*)(p.k->ws + OFF_MOD))[((size_t)l * 17 + r) * 3072 + cc] = s + p.k->b_mod[l * 3072 + cc]; }
          __syncthreads();
      } }
}

DI void phase_prep(LAS unsigned char* lds, const Params& p, int layer) {
    const int tid = ltid(p.wvid), lane = tid & 63, wv = tid >> 6;
    bf16_t* Z = (bf16_t*)(p.k->ws + OFF_ZQK);
    { const bool isA = lane < 32; const bool isK = isA ? (lane >= 16) : (lane >= 48);
      const float* gptr = isA ? p.k->da_qk_gain + (layer * 2 + (isK ? 1 : 0)) * 32 + (lane & 1) * 16 : p.k->na_qk_gain + (layer * 2 + (isK ? 1 : 0)) * 64 + (lane & 3) * 16;
      float gn[16];
#pragma unroll
      for (int j = 0; j < 16; ++j) gn[j] = gptr[j];
      const int stride = gridDim.x * 8;
      for (int rowa = lbid() * 8 + wv; rowa < TT; rowa += 2 * stride) {
          u32x4 ua[2][2];
#pragma unroll
          for (int r2 = 0; r2 < 2; ++r2) { const int row = rowa + r2 * stride; if (row < TT) { const u32x4* zq = (const u32x4*)(Z + (size_t)row * 1024 + lane * 16); ua[r2][0] = zq[0]; ua[r2][1] = zq[1]; } }
#pragma unroll
          for (int r2 = 0; r2 < 2; ++r2) { const int row = rowa + r2 * stride; if (row < TT) {
          u32x4* zp = (u32x4*)(Z + (size_t)row * 1024 + lane * 16); const u32x4 u0 = ua[r2][0], u1 = ua[r2][1];
          float v[16]; v[0] = bflo(u0.x); v[1] = bfhi(u0.x); v[2] = bflo(u0.y); v[3] = bfhi(u0.y); v[4] = bflo(u0.z); v[5] = bfhi(u0.z); v[6] = bflo(u0.w); v[7] = bfhi(u0.w);
          v[8] = bflo(u1.x); v[9] = bfhi(u1.x); v[10] = bflo(u1.y); v[11] = bfhi(u1.y); v[12] = bflo(u1.z); v[13] = bfhi(u1.z); v[14] = bflo(u1.w); v[15] = bfhi(u1.w);
          float ss = 0.f;
#pragma unroll
          for (int j = 0; j < 16; ++j) ss += v[j] * v[j];
          ss += __shfl_xor(ss, 1); const float ss2 = ss + __shfl_xor(ss, 2);
          const float r = isA ? rsqrtf(ss * (1.f / 32.f) + EPS) : rsqrtf(ss2 * (1.f / 64.f) + EPS);
#pragma unroll
          for (int j = 0; j < 16; ++j) v[j] = v[j] * r * gn[j];
          const bool rope = isA && row < TL;
          const int n = row & (SEQ - 1); const float* rt = (const float*)(p.k->ws + OFF_ROPE) + n * 32;
          float cs[16], sn[16];
#pragma unroll
          for (int j4 = 0; j4 < 4; ++j4) { f32x4 c4 = {1.f, 1.f, 1.f, 1.f}, s4 = {0.f, 0.f, 0.f, 0.f}; if (rope) { c4 = *(const f32x4*)(rt + 4 * j4); s4 = *(const f32x4*)(rt + 16 + 4 * j4); }
#pragma unroll
              for (int j = 0; j < 4; ++j) { cs[4 * j4 + j] = c4[j]; sn[4 * j4 + j] = s4[j]; } }
#pragma unroll
          for (int j = 0; j < 16; ++j) { const float other = __shfl_xor(v[j], 1);
              v[j] = (lane & 1) ? (other * sn[j] + v[j] * cs[j]) : (v[j] * cs[j] - other * sn[j]); }
          u32x4 o0, o1; o0.x = pack2(v[0], v[1]); o0.y = pack2(v[2], v[3]); o0.z = pack2(v[4], v[5]); o0.w = pack2(v[6], v[7]);
          o1.x = pack2(v[8], v[9]); o1.y = pack2(v[10], v[11]); o1.z = pack2(v[12], v[13]); o1.w = pack2(v[14], v[15]); zp[0] = o0; zp[1] = o1;
          } }
      } }
    { const bf16_t* CQ = (const bf16_t*)(p.k->ws + OFF_CQ); LAS float* part = (LAS float*)lds;
      const int ch = tid & 255, hf = tid >> 8;
      for (int item = lbid(); item < NB * NSLOT * 2; item += gridDim.x) {
          const int dir = item & 1, slot = (item >> 1) % NSLOT, b = (item >> 1) / NSLOT;
          const int row0 = slot < 32 ? b * SEQ + 64 * slot : TL + b * CTX + 64 * (slot - 32);
          float* G = (float*)(p.k->ws + OFF_G) + (size_t)dir * TT * 256 + (size_t)row0 * 256 + ch;
          const float* misc = (const float*)(p.k->ws + OFF_MISC);
          const float lbv = __expf(misc[MISC_LOGLB + (dir * 4 + layer) * 256 + ch]), omlb = __expf(misc[MISC_LOG1M + (dir * 4 + layer) * 256 + ch]);
          auto logf_gate = [&](float f) { const float sg = __builtin_amdgcn_rcpf(1.f + __builtin_amdgcn_exp2f(-1.4426950408889634f * f)); return __logf(__builtin_fmaf(omlb, sg, lbv)); };
          float ps = 0.f, gv[32];
#pragma unroll
          for (int t8 = 0; t8 < 32; t8 += 8) {
              float fv[8];
#pragma unroll
              for (int q = 0; q < 8; ++q) fv[q] = G[(size_t)(32 * hf + t8 + q) * 256];
#pragma unroll
              for (int q = 0; q < 8; ++q) { gv[t8 + q] = logf_gate(fv[q]); ps += gv[t8 + q]; }
          }
          __syncthreads(); part[hf * 256 + ch] = ps; __syncthreads();
          const float p0 = part[ch], p1 = part[256 + ch]; const float blast = p0 + p1; const float mref = dir == 0 ? p0 : p1;
          float bc = dir == 0 ? (hf ? p0 : 0.f) : (hf ? 0.f : p1); const float elm = __expf(blast - mref);
          unsigned* QK = (unsigned*)G;
          bf16_t* KDT = (bf16_t*)(p.k->ws + OFF_KDT) + (((size_t)dir * NB + b) * 256 + ch) * KEYS + 64 * slot + 32 * hf;
          const bf16_t* cq = CQ + (size_t)row0 * 256 + ch;
#pragma unroll
          for (int o8 = 0; o8 < 4; ++o8) {
              float kv[8], cqv[8];
#pragma unroll
              for (int q = 0; q < 8; ++q) { const int tl = dir == 0 ? (o8 * 8 + q) : (31 - (o8 * 8 + q)); cqv[q] = bf2f(cq[(size_t)(32 * hf + tl) * 256]); }
#pragma unroll
              for (int q = 0; q < 8; ++q) {
                  const int tl = dir == 0 ? (o8 * 8 + q) : (31 - (o8 * 8 + q)); const int tau = 32 * hf + tl;
                  const float g = dir == 0 ? gv[o8 * 8 + q] : gv[31 - (o8 * 8 + q)]; bc += g;
                  const float qv = cqv[q]; const float k = 1.f - __expf(g);
                  const float e = __expf(bc - mref); const float kdv = k * __builtin_amdgcn_rcpf(e);
                  QK[(size_t)tau * 256] = pack2(qv * e, kdv);
                  kv[dir == 0 ? q : 7 - q] = kdv * elm;
              }
              const int t8 = dir == 0 ? o8 * 8 : 24 - o8 * 8;
              *(u32x4*)(KDT + t8) = __builtin_bit_cast(u32x4, pack8(kv[0], kv[1], kv[2], kv[3], kv[4], kv[5], kv[6], kv[7]));
          }
          if (hf == 0) { float* ev = (float*)(p.k->ws + OFF_EV) + (((size_t)dir * NB + b) * NSLOT + slot) * 3 * 256 + ch; ev[0] = __expf(blast); ev[256] = __expf(mref); ev[512] = __expf(blast - mref); }
      } }
}

DI void phase_post(const Params& p, int layer) {
    const int lane = ltid(p.wvid) & 63, wv = ltid(p.wvid) >> 6;
    const unsigned* O0 = (const unsigned*)(p.k->ws + OFF_G); const unsigned* O1 = O0 + (size_t)TT * 256; bf16_t* Y = (bf16_t*)(p.k->ws + OFF_YG);
    const f32x4 gn = *(const f32x4*)(p.k->hg_norm_gain + layer * 64 + (lane & 15) * 4);
    const int stride = gridDim.x * 8;
    for (int rowa = lbid() * 8 + wv; rowa < TT; rowa += 4 * stride) {
        u32x4 a[4], bq[4]; u32x2 sgv[4];
#pragma unroll
        for (int r4 = 0; r4 < 4; ++r4) { const int row = rowa + r4 * stride; if (row < TT) { a[r4] = *(const u32x4*)(O0 + (size_t)row * 256 + lane * 4); bq[r4] = *(const u32x4*)(O1 + (size_t)row * 256 + lane * 4);
            sgv[r4] = *(const u32x2*)(Y + (size_t)row * 1024 + 512 + lane * 4); } }
#pragma unroll
        for (int r4 = 0; r4 < 4; ++r4) { const int row = rowa + r4 * stride; if (row < TT) {
            f32x4 v; v[0] = bflo(a[r4].x) + bflo(bq[r4].x); v[1] = bflo(a[r4].y) + bflo(bq[r4].y); v[2] = bflo(a[r4].z) + bflo(bq[r4].z); v[3] = bflo(a[r4].w) + bflo(bq[r4].w);
            float ss = v[0] * v[0] + v[1] * v[1] + v[2] * v[2] + v[3] * v[3];
            ss += __shfl_xor(ss, 1); ss += __shfl_xor(ss, 2); ss += __shfl_xor(ss, 4); ss += __shfl_xor(ss, 8);
            const float r = rsqrtf(ss * (1.f / 64.f) + EPS);
            const u32x2 sg = sgv[r4]; u32x2 o;
            o.x = pack2(v[0] * r * gn[0] * bflo(sg.x), v[1] * r * gn[1] * bfhi(sg.x)); o.y = pack2(v[2] * r * gn[2] * bflo(sg.y), v[3] * r * gn[3] * bfhi(sg.y));
            *(u32x2*)(Y + (size_t)row * 1024 + 512 + lane * 4) = o; } }
    }
}

DI void phase_mix(LAS unsigned char* lds, const Params& p, int layer) {
    const int tid = ltid(p.wvid), wv = tid >> 6, lane = tid & 63; const bool need_ctx = layer < DEPTH - 1;
#if defined(SELC)
    const int sel = SELC;
#elif defined(MIXSEL)
    const int sel = p.pad_ ? MIXSEL : 15;
#else
    const int sel = 15;
#endif
    if ((sel & 1) && lbid() < 64) hgrn_item(lds, p, lbid() * 2 + (wv >> 2), wv >> 2, wv & 3, lane);
    if ((sel & 2) && lbid() >= 128) {
        const int u = lbid() - 128; SchedOne S; S.u.pm = u >> 4; S.u.pn = u & 15; S.u.sub = 0; S.u.nt = 64;
        S.u.A = (const char*)(p.k->ws + OFF_DFTL) + (size_t)S.u.pm * 256 * 4096 * 2; S.u.B = (const char*)(p.k->ws + OFF_FBL) + (size_t)S.u.pn * 256 * 4096 * 2;
        EpiFour E; E.Y = (bf16_t*)(p.k->ws + OFF_YG); E.rowbase = S.u.pn * SEQ;
        gemm_phase<true>(lds, p.wvid, 4096, 4096, S, E);
        if (need_ctx && u < 16) { SchedOne S2; S2.u.pm = 0; S2.u.pn = u; S2.u.sub = 0; S2.u.nt = 8;
            S2.u.A = (const char*)(p.k->ws + OFF_DFTC); S2.u.B = (const char*)(p.k->ws + OFF_FBC) + (size_t)u * 256 * 512 * 2;
            EpiFour E2; E2.Y = E.Y; E2.rowbase = TL + u * CTX; gemm_phase<true>(lds, p.wvid, 512, 512, S2, E2); }
    }
    int* ctr = (int*)(p.k->ws + OFF_MISC) + MISC_CTR + layer + p.pad_; LAS int* slot = (LAS int*)(lds + LDS_MISC);
    const int nitems = need_ctx ? 1152 : 1024;
    __syncthreads();
    if (tid == 0) *slot = atomicAdd(ctr, 1);
    __syncthreads();
    for (;;) {
        const int it = *slot;
        __syncthreads();
        if (it >= nitems) break;
        if (tid == 0) *slot = atomicAdd(ctr, 1);
        if (it < 512 && (sel & 4)) { const int b = it >> 5, h = (it >> 3) & 3, qb = it & 7; attn_unit<0>(lds, p, layer, b, h, 0, b * SEQ + qb * 256, 0); }
        if (it >= 512 && it < 1024 && (sel & 8)) { const int j = it - 512; const int b = j >> 5, h = (j >> 3) & 3, R = j & 7; attn_unit<1>(lds, p, layer, b, h, 2, b * SEQ + R * 256, R); }
        if (it >= 1024 && it < 1088 && (sel & 4)) { const int j = it - 1024; const int b = j >> 2, h = j & 3; attn_unit<0>(lds, p, layer, b, h, 1, TL + b * CTX, 0); }
        if (it >= 1088 && (sel & 8)) { const int j = it - 1088; const int b = j >> 2, h = j & 3; attn_unit<1>(lds, p, layer, b, h, 1, TL + b * CTX, 0); }
        __syncthreads();
    }
}

DI void run_phase(LAS unsigned char* lds, const Params& pin, int ph) {
    Params p = pin; asm volatile("" : "+s"(p.k));
#ifdef ONLY
    if (ph == 0) return;
#else
    if (ph == 0) { phase_pro(lds, p); return; }
#endif
#ifdef PROBE_SUB
    const int layer = ph >= 100 ? 0 : (ph - 1) / 7, sub = ph >= 100 ? ph - 100 : (ph - 1) % 7; const bool last = layer == DEPTH - 1;
#else
    const int layer = (ph - 1) / 7, sub = (ph - 1) % 7; const bool last = layer == DEPTH - 1;
#endif
#ifdef ONLY
    if (sub != ONLY) return;
#endif
    switch (sub) {
    case 0: if (layer == 0) phase_weights(lds, p, 0, lbid(), gridDim.x); phase_h(p, layer); break;
    case 1: { SchedG1 S; S.nM = TT / 256; S.nN = 16; S.G = gridDim.x; S.c = lbid(); S.A = (const char*)(p.k->ws + OFF_H); S.B = (const char*)(p.k->ws + wsel(layer) + OFF_WIN);
        EpiG1 E; E.ws = p.k->ws; E.layer = layer; gemm_phase<true>(lds, p.wvid, 1024, 1024, S, E); } break;
    case 2: phase_prep(lds, p, layer); break;
    case 3: phase_mix(lds, p, layer); break;
    case 4: phase_post(p, layer); break;
    case 5: { SchedG2 S; S.nM = last ? TL / 256 : TT / 256; S.G = gridDim.x; S.c = lbid(); S.YG = (const char*)(p.k->ws + OFF_YG); S.WUP = (const char*)(p.k->ws + wsel(layer) + OFF_WUP);
        S.H = (const char*)(p.k->ws + OFF_H); S.WM = (const char*)(p.k->ws + wsel(layer) + OFF_WM);
        EpiG2 E; E.brs = (u32x4*)(p.k->ws + OFF_BRS) + (size_t)lbid() * 512 * 16; E.accs = (u32x4*)(p.k->ws + OFF_ACCS) + (size_t)lbid() * 512 * 16; E.ACC = (bf16_t*)(p.k->ws + OFF_ACC);
        const int su = lbid() & 63, pr = lbid() >> 6; E.t4 = (u32x4*)(p.k->ws + OFF_T4) + ((size_t)(su * 4 + pr) * 16) * 512;
        gemm_phase<true>(lds, p.wvid, 1024, 1024, S, E);
        if (!last) {
            const int tid = ltid(p.wvid); LAS unsigned* sl = (LAS unsigned*)(lds + LDS_MISC + 32);
            __syncthreads();
            if (tid == 0) { __builtin_amdgcn_fence(__ATOMIC_RELEASE, "agent"); asm volatile("s_waitcnt vmcnt(0)" ::: "memory");
                *sl = xb_add((unsigned*)(p.k->ws + OFF_BAR) + XB_SPLITCNT + layer * 64 + su, 1u); }
            __syncthreads();
            if (*sl == 3u) {
                __builtin_amdgcn_fence(__ATOMIC_ACQUIRE, "agent"); asm volatile("s_waitcnt vmcnt(0)" ::: "memory");
                int pm, pn; tile_order(2 * (int)gridDim.x + su, S.nM, 4, pm, pn);
                const int w2 = tid >> 6, fr = tid & 15, fq = (tid >> 4) & 3; const int row0 = pm * 256 + (w2 >> 2) * 64 + fr, col0 = pn * 256 + (w2 & 3) * 32 + 8 * fq;
                const u32x4* T = (const u32x4*)(p.k->ws + OFF_T4) + ((size_t)(su * 4) * 16) * 512 + tid; bf16_t* ACC = (bf16_t*)(p.k->ws + OFF_ACC);
                for (int idx = 0; idx < 16; ++idx) {
                    u32x4 tq[4];
#pragma unroll
                    for (int q = 0; q < 4; ++q) tq[q] = T[((size_t)q * 16 + idx) * 512];
                    float t[8] = {0.f, 0.f, 0.f, 0.f, 0.f, 0.f, 0.f, 0.f};
#pragma unroll
                    for (int q = 0; q < 4; ++q) { t[0] += bflo(tq[q].x); t[1] += bfhi(tq[q].x); t[2] += bflo(tq[q].y); t[3] += bfhi(tq[q].y); t[4] += bflo(tq[q].z); t[5] += bfhi(tq[q].z); t[6] += bflo(tq[q].w); t[7] += bfhi(tq[q].w); }
                    u32x4 o; o.x = pack2(t[0], t[1]); o.y = pack2(t[2], t[3]); o.z = pack2(t[4], t[5]); o.w = pack2(t[6], t[7]);
                    const int ai = idx >> 3, m = (idx >> 1) & 3, bj = idx & 1;
                    *(u32x4*)(ACC + (size_t)(row0 + ai * 128 + m * 16) * 1024 + col0 + bj * 128) = o;
                }
            }
        } }
        break;
    case 7: break;
    case 6: { SchedG3 S; S.nM = last ? TL / 256 : TT / 256; S.G = gridDim.x; S.c = lbid(); S.A = (const char*)(p.k->ws + OFF_ACC); S.B = (const char*)(p.k->ws + wsel(layer) + OFF_WO);
        EpiG3 E; E.p = p; E.layer = layer; gemm_phase<true>(lds, p.wvid, 1024, 1024, S, E);
        if (!last && lbid() >= 64) phase_weights(lds, p, layer + 1, lbid() - 64, 192); }
        break;
    }
}

constexpr int NPHASE = 1 + 7 * DEPTH;

__global__ void __launch_bounds__(512, 2) mega(KArgs ka) {
    Params p; p.k = (KPtr)__builtin_amdgcn_kernarg_segment_ptr(); p.pad_ = 0; p.wvid = __builtin_amdgcn_readfirstlane((int)threadIdx.x >> 6);
    extern __shared__ __attribute__((aligned(16))) unsigned char shm[];
    LAS unsigned char* lds = (LAS unsigned char*)shm;
#if COOP
    cg::grid_group grid = cg::this_grid();
    volatile LAS unsigned* xst = (volatile LAS unsigned*)(lds + LDS_MISC + 16);
    { const int t0 = ltid(p.wvid); if (t0 == 0) { xst[0] = 0u; xst[1] = 0u; } __syncthreads(); }
    const XcdBarrier xb = xcd_barrier_post((unsigned*)(p.k->ws + OFF_BAR), xst, ltid(p.wvid));
#ifdef PROBE_SUB
    constexpr int NPRE = 1 + PROBE_REP;
    for (int s = 0; s < NPRE + NPHASE; ++s) {
        const int ph = s < NPRE ? (s == 0 ? 0 : 100 + PROBE_SUB) : s - NPRE;
        p.pad_ = (s >= 1 && s < NPRE) ? 4 + ((s - 1) & 3) : 0;
        run_phase(lds, p, ph); if (s + 1 < NPRE + NPHASE) { if (s == 0) grid.sync(); else xcd_barrier(xb, ltid(p.wvid)); }
    }
#else
    for (int ph = p.k->phase_lo; ph < p.k->phase_hi; ++ph) { run_phase(lds, p, ph); if (ph + 1 < p.k->phase_hi) { if (p.k->phase_hi < 0) grid.sync(); else xcd_barrier(xb, ltid(p.wvid)); } }
#endif
#else
    for (int ph = p.k->phase_lo; ph < p.k->phase_hi; ++ph) run_phase(lds, p, ph);
#endif
}

extern "C" void kernel_launch(void* const* d_in, const int* in_sizes, int n_in, void* d_out, int out_size, void* d_ws, size_t ws_size, hipStream_t stream) {
    if (ws_size < OFF_END) { fprintf(stderr, "workspace too small: %zu < %zu\n", ws_size, (size_t)OFF_END); return; }
    KArgs p{};
    const float** f = (const float**)&p;
    for (int i = 0; i < 18; ++i) f[i] = (const float*)d_in[i];
    p.out = (float*)d_out; p.ws = (unsigned char*)d_ws;
    static bool attr = false;
    if (!attr) { (void)hipFuncSetAttribute((const void*)mega, hipFuncAttributeMaxDynamicSharedMemorySize, LDS_BYTES); attr = true; }
#if COOP
    p.phase_lo = 0; p.phase_hi = NPHASE;
    (void)hipMemsetAsync((unsigned char*)d_ws + OFF_BAR, 0, 16384, stream);
    void* args[] = {&p};
    hipError_t e = hipLaunchCooperativeKernel((const void*)mega, dim3(256), dim3(512), args, LDS_BYTES, stream);
    if (e != hipSuccess) fprintf(stderr, "cooperative launch failed: %s\n", hipGetErrorString(e));
#else
    for (int ph = 0; ph < NPHASE; ++ph) { p.phase_lo = ph; p.phase_hi = ph + 1; hipLaunchKernelGGL(mega, dim3(256), dim3(512), LDS_BYTES, stream, p); }
#endif
}
```
